# Optimizing an MI355X kernel written in HIP

```python
import jax, jax.numpy as jnp
from jax import lax
import numpy as np

D_MODEL = 1024
BATCH = 8
SEQ = 4096
DEPTH = 2

N_MEM = 256
HEAD_DIM = 64
MIX_HEADS = 12
MIX_WIDTH = MIX_HEADS * HEAD_DIM
MEM_HEADS = 4
MEM_WIDTH = MEM_HEADS * HEAD_DIM
CAT_WIDTH = MIX_WIDTH + MEM_WIDTH
D_FF = 2816
CONV_WIDTH = 4
LRU_C = 8.0
BLOCK_Q = 128
NORM_EPS = 1e-6
F32 = jnp.float32

kernel_name = "hybrid_rglru_fox_macaron_memxattn"


def rmsnorm(x, g):
    xf = x.astype(F32)
    y = xf * lax.rsqrt(jnp.mean(xf * xf, axis=-1, keepdims=True) + NORM_EPS)
    return (y * g.astype(F32)).astype(x.dtype)


def swiglu(x, w_in, w_out):
    gate, up = jnp.split(x @ w_in, 2, axis=-1)
    return (jax.nn.silu(gate) * up) @ w_out


def memory_keys_values(mem, norm_g, w_kv, k_norm_g):
    B, N, _ = mem.shape
    k, v = jnp.split(rmsnorm(mem, norm_g) @ w_kv, 2, axis=-1)
    k = rmsnorm(k.reshape(B, N, MEM_HEADS, HEAD_DIM), k_norm_g)
    v = v.reshape(B, N, MEM_HEADS, HEAD_DIM)
    return k, v


def memory_cross_attention(q, mk, mv):
    B, S = q.shape[:2]
    s = jnp.einsum('bshd,bnhd->bhsn', q, mk, preferred_element_type=F32) * (HEAD_DIM ** -0.5)
    p = jax.nn.softmax(s, axis=-1)
    o = jnp.einsum('bhsn,bnhd->bshd', p.astype(mv.dtype), mv)
    return o.reshape(B, S, MEM_WIDTH)


def causal_depthwise_conv(u, w, b):
    S = u.shape[1]
    up = jnp.pad(u, ((0, 0), (CONV_WIDTH - 1, 0), (0, 0)))
    y = b
    for tap in range(CONV_WIDTH):
        y = y + up[:, tap:tap + S] * w[tap]
    return y


def _linear_recurrence_combine(c1, c2):
    a1, b1 = c1
    a2, b2 = c2
    return a1 * a2, a2 * b1 + b2


def rg_lru(xc, w_rg, b_rg, w_ig, b_ig, lam):
    B, S, W = xc.shape
    xh = xc.reshape(B, S, MIX_HEADS, HEAD_DIM)
    r = jax.nn.sigmoid(jnp.einsum('bshi,hij->bshj', xh, w_rg).reshape(B, S, W) + b_rg).astype(F32)
    gi = jax.nn.sigmoid(jnp.einsum('bshi,hij->bshj', xh, w_ig).reshape(B, S, W) + b_ig).astype(F32)
    log_a = -LRU_C * r * jax.nn.softplus(-lam.astype(F32))
    a = jnp.exp(log_a)
    bx = jnp.sqrt(-jnp.expm1(2.0 * log_a)) * (gi * xc.astype(F32))
    _, hs = lax.associative_scan(_linear_recurrence_combine, (a, bx), axis=1)
    return hs.astype(xc.dtype)


def forgetting_attention(q, k, v, f_logit, b_f, q_g, k_g):
    B, S, _ = q.shape
    q = rmsnorm(q.reshape(B, S, MIX_HEADS, HEAD_DIM), q_g).transpose(0, 2, 1, 3)
    k = rmsnorm(k.reshape(B, S, MIX_HEADS, HEAD_DIM), k_g).transpose(0, 2, 1, 3)
    v = v.reshape(B, S, MIX_HEADS, HEAD_DIM).transpose(0, 2, 1, 3)
    log_f = jax.nn.log_sigmoid(f_logit.astype(F32) + b_f.astype(F32))
    cum = jnp.cumsum(log_f, axis=1).transpose(0, 2, 1)
    nb = S // BLOCK_Q
    q_blocks = q.reshape(B, MIX_HEADS, nb, BLOCK_Q, HEAD_DIM).transpose(2, 0, 1, 3, 4)
    c_blocks = cum.reshape(B, MIX_HEADS, nb, BLOCK_Q).transpose(2, 0, 1, 3)
    key_pos = jnp.arange(S)
    scale = HEAD_DIM ** -0.5

    def one_block(args):
        qb, cb, bi = args
        s = jnp.einsum('bhqd,bhkd->bhqk', qb, k, preferred_element_type=F32) * scale
        s = s + cb[..., None] - cum[:, :, None, :]
        q_pos = bi * BLOCK_Q + jnp.arange(BLOCK_Q)
        s = jnp.where(key_pos[None, :] <= q_pos[:, None], s, -jnp.inf)
        p = jax.nn.softmax(s, axis=-1)
        return jnp.einsum('bhqk,bhkd->bhqd', p.astype(v.dtype), v)

    o = lax.map(one_block, (q_blocks, c_blocks, jnp.arange(nb)))
    return o.transpose(1, 0, 3, 2, 4).reshape(B, S, MIX_WIDTH)


def setup_inputs(seed: int = 0) -> dict:
    key = jax.random.key(seed)
    ks = iter(jax.random.split(key, 40))
    n_lru = (DEPTH + 1) // 2
    n_fox = DEPTH // 2

    def nrm(shape, fan_in):
        return jax.random.normal(next(ks), shape, F32) * (fan_in ** -0.5)

    def gain(shape):
        return 1.0 + 0.1 * jax.random.normal(next(ks), shape, F32)

    def small(shape, s=0.1):
        return s * jax.random.normal(next(ks), shape, F32)

    x = jax.random.normal(next(ks), (BATCH, SEQ, D_MODEL), F32)
    mem = jax.random.normal(next(ks), (BATCH, N_MEM, D_MODEL), F32)
    u = jax.random.uniform(next(ks), (n_lru, MIX_WIDTH), F32, minval=0.9, maxval=0.999)
    a0 = u ** (1.0 / LRU_C)
    lru_lambda = jnp.log(a0) - jnp.log1p(-a0)
    return {
        "x": x,
        "mem": mem,
        "mem_norm_g": gain((D_MODEL,)),
        "mem_w_kv": nrm((D_MODEL, 2 * MEM_WIDTH), D_MODEL),
        "mem_k_norm_g": gain((HEAD_DIM,)),
        "ffn1_norm_g": gain((DEPTH, D_MODEL)),
        "ffn1_w_in": nrm((DEPTH, D_MODEL, 2 * D_FF), D_MODEL),
        "ffn1_w_out": nrm((DEPTH, D_FF, D_MODEL), D_FF),
        "mix_norm_g": gain((DEPTH, D_MODEL)),
        "mix_w_out": nrm((DEPTH, CAT_WIDTH, D_MODEL), CAT_WIDTH),
        "memq_norm_g": gain((DEPTH, HEAD_DIM)),
        "ffn2_norm_g": gain((DEPTH, D_MODEL)),
        "ffn2_w_in": nrm((DEPTH, D_MODEL, 2 * D_FF), D_MODEL),
        "ffn2_w_out": nrm((DEPTH, D_FF, D_MODEL), D_FF),
        "lru_w_in": nrm((n_lru, D_MODEL, 2 * MIX_WIDTH + MEM_WIDTH), D_MODEL),
        "lru_conv_w": nrm((n_lru, CONV_WIDTH, MIX_WIDTH), CONV_WIDTH),
        "lru_conv_b": small((n_lru, MIX_WIDTH), 0.01),
        "lru_w_rg": nrm((n_lru, MIX_HEADS, HEAD_DIM, HEAD_DIM), HEAD_DIM),
        "lru_b_rg": small((n_lru, MIX_WIDTH)),
        "lru_w_ig": nrm((n_lru, MIX_HEADS, HEAD_DIM, HEAD_DIM), HEAD_DIM),
        "lru_b_ig": small((n_lru, MIX_WIDTH)),
        "lru_lambda": lru_lambda,
        "fox_w_in": nrm((n_fox, D_MODEL, 3 * MIX_WIDTH + MIX_HEADS + MEM_WIDTH), D_MODEL),
        "fox_b_f": jax.random.uniform(next(ks), (n_fox, MIX_HEADS), F32, minval=1.0, maxval=6.0),
        "fox_q_norm_g": gain((n_fox, HEAD_DIM)),
        "fox_k_norm_g": gain((n_fox, HEAD_DIM)),
    }


def reference(x, mem, mem_norm_g, mem_w_kv, mem_k_norm_g,
              ffn1_norm_g, ffn1_w_in, ffn1_w_out,
              mix_norm_g, mix_w_out, memq_norm_g,
              ffn2_norm_g, ffn2_w_in, ffn2_w_out,
              lru_w_in, lru_conv_w, lru_conv_b, lru_w_rg, lru_b_rg, lru_w_ig, lru_b_ig, lru_lambda,
              fox_w_in, fox_b_f, fox_q_norm_g, fox_k_norm_g):
    B, S, _ = x.shape
    mem_k, mem_v = memory_keys_values(mem, mem_norm_g, mem_w_kv, mem_k_norm_g)
    h = x
    for i in range(DEPTH):
        j = i // 2
        h = h + 0.5 * swiglu(rmsnorm(h, ffn1_norm_g[i]), ffn1_w_in[i], ffn1_w_out[i])
        hn = rmsnorm(h, mix_norm_g[i])
        if i % 2 == 0:
            x_br, g_br, q_mem = jnp.split(hn @ lru_w_in[j], [MIX_WIDTH, 2 * MIX_WIDTH], axis=-1)
            xc = causal_depthwise_conv(x_br, lru_conv_w[j], lru_conv_b[j])
            tok = rg_lru(xc, lru_w_rg[j], lru_b_rg[j], lru_w_ig[j], lru_b_ig[j], lru_lambda[j])
            tok = tok * jax.nn.gelu(g_br)
        else:
            q, k, v, f_logit, q_mem = jnp.split(
                hn @ fox_w_in[j],
                [MIX_WIDTH, 2 * MIX_WIDTH, 3 * MIX_WIDTH, 3 * MIX_WIDTH + MIX_HEADS], axis=-1)
            tok = forgetting_attention(q, k, v, f_logit, fox_b_f[j], fox_q_norm_g[j], fox_k_norm_g[j])
        q_mem = rmsnorm(q_mem.reshape(B, S, MEM_HEADS, HEAD_DIM), memq_norm_g[i])
        cross = memory_cross_attention(q_mem, mem_k, mem_v)
        h = h + jnp.concatenate([tok, cross], axis=-1) @ mix_w_out[i]
        h = h + 0.5 * swiglu(rmsnorm(h, ffn2_norm_g[i]), ffn2_w_in[i], ffn2_w_out[i])
    return h
```

```cpp
#include <hip/hip_runtime.h>
#include <cstdio>
#include <cstdint>
namespace pg8 {
#define PG8_LAS __attribute__((address_space(3)))
typedef unsigned short bf16_t;
typedef short bf16x8 __attribute__((ext_vector_type(8)));
typedef float f32x4 __attribute__((ext_vector_type(4)));
typedef unsigned u32x4 __attribute__((ext_vector_type(4)));
constexpr int BM = 256, BK = 64, HALF = 128, HTB = HALF * BK * 2  , STAGE_BYTES = 8 * HTB, NXCD = 8, WGM = 8;

__host__ __device__ __forceinline__ int lds_byte(int r, int c) { const int st = (r >> 4) * 2 + (c >> 5), rr = r & 15, cc = c & 31, ob = rr * 64 + cc * 2; return st * 1024 + (ob ^ (((ob >> 9) & 1) << 5)); }
__host__ __device__ __forceinline__ void stage_rc(int b, int& R, int& C) { const int st = b / 1024, sb = b % 1024, swz = sb ^ (((sb >> 9) & 1) << 5); R = (st >> 1) * 16 + swz / 64; C = (st & 1) * 32 + (swz % 64) / 2; }
__host__ __device__ __forceinline__ int perm32(int rho) { const int n = rho >> 4, i = rho & 15; return 8 * (i >> 2) + 4 * n + (i & 3); }

struct Unit { int pm, pn; };
struct Gemm { const bf16_t* A; const bf16_t* Bt; int M, N, K; };

struct StaticOrder {
    int nM, nN, nwg, G, c;
    __host__ __device__ void init(int M, int N, int G_, int c_) { nM = M / BM; nN = N / BM; nwg = nM * nN; G = G_; c = c_; }
    __host__ __device__ bool next(int i, Unit& u) const {
        const long L = (long)i * G + c; if (L >= nwg) return false;
        int wgid = (int)L; { const int q = nwg / NXCD, r = nwg % NXCD, xcd = wgid % NXCD, off = wgid / NXCD; wgid = (xcd < r ? xcd * (q + 1) : r * (q + 1) + (xcd - r) * q) + off; }
        const int nig = WGM * nN, gid = wgid / nig, fm = gid * WGM, gsz = (nM - fm) < WGM ? (nM - fm) : WGM;
        u.pm = fm + ((wgid % nig) % gsz); u.pn = (wgid % nig) / gsz; return true;
    }
    __device__ __forceinline__ void a_ready(const Unit&) const {}
    __device__ __forceinline__ void done(const Unit&) const {}
};

typedef float f32x2_cv __attribute__((ext_vector_type(2))); typedef __bf16 bf16x2_cv __attribute__((ext_vector_type(2)));
__device__ __forceinline__ unsigned cvt_pk_bf16(float lo, float hi) { f32x2_cv v = {lo, hi}; bf16x2_cv b = __builtin_convertvector(v, bf16x2_cv); return __builtin_bit_cast(unsigned, b); }
typedef float f32x2 __attribute__((ext_vector_type(2)));
constexpr float NORM_EPS_F = 1e-6f;
constexpr float LOG2E_F = 1.4426950408889634f;
__device__ __forceinline__ void rows_rstd(const float* ssq, int row0, float (&rs)[2][4]) {
    f32x4 p[2][4];
#pragma unroll
    for (int ai = 0; ai < 2; ++ai)
#pragma unroll
        for (int m = 0; m < 4; ++m) p[ai][m] = *(const f32x4*)(ssq + (size_t)(row0 + ai * HALF + m * 16) * 4);
#pragma unroll
    for (int ai = 0; ai < 2; ++ai)
#pragma unroll
        for (int m = 0; m < 4; ++m) rs[ai][m] = __builtin_amdgcn_rsqf(((p[ai][m][0] + p[ai][m][1]) + (p[ai][m][2] + p[ai][m][3])) * (1.0f / 1024.0f) + NORM_EPS_F);
    asm volatile("" ::: "memory");
}
__device__ __forceinline__ float fast_sigmoid(float x) { return __builtin_amdgcn_rcpf(1.0f + __builtin_amdgcn_exp2f(-x * LOG2E_F)); }

struct EpiSwiglu {
    static constexpr bool PERM = true, AFTER_DRAIN = false; static constexpr int ldc = 2816;
    bf16_t* O; const float* ssq;
    __device__ __forceinline__ void operator()(const f32x4 (&acc)[2][2][4][2], const Unit& u, int wr, int wc, int fr, int fq) const {
        const int row0 = u.pm * BM + wr * 64 + fr; const int col0 = u.pn * HALF + wc * 32 + 8 * fq;
        float rsv[2][4]; rows_rstd(ssq, row0, rsv);
#pragma unroll
        for (int ai = 0; ai < 2; ++ai)
#pragma unroll
            for (int m = 0; m < 4; ++m) { const int row = row0 + ai * HALF + m * 16; const float rs = rsv[ai][m];
                const float c1 = -rs * LOG2E_F, c2 = rs * rs;
                const f32x4 g0 = acc[ai][0][m][0], g1 = acc[ai][0][m][1], u0 = acc[ai][1][m][0], u1 = acc[ai][1][m][1];
                f32x4 t0 = g0 * c1, t1 = g1 * c1, p0 = (g0 * u0) * c2, p1 = (g1 * u1) * c2;
#pragma unroll
                for (int j = 0; j < 4; ++j) { t0[j] = __builtin_amdgcn_exp2f(t0[j]); t1[j] = __builtin_amdgcn_exp2f(t1[j]); }
                t0 = t0 + 1.0f; t1 = t1 + 1.0f;
#pragma unroll
                for (int j = 0; j < 4; ++j) { t0[j] = __builtin_amdgcn_rcpf(t0[j]); t1[j] = __builtin_amdgcn_rcpf(t1[j]); }
                const f32x4 v0 = p0 * t0, v1 = p1 * t1;
                u32x4 w; w.x = cvt_pk_bf16(v0[0], v0[1]); w.y = cvt_pk_bf16(v0[2], v0[3]); w.z = cvt_pk_bf16(v1[0], v1[1]); w.w = cvt_pk_bf16(v1[2], v1[3]);
                *(u32x4*)(O + (size_t)row * ldc + col0) = w; asm volatile("" ::: "memory"); }
    }
};

template <bool HALFSTEP> struct EpiRes {
    static constexpr bool PERM = true, AFTER_DRAIN = false; static constexpr float alpha = HALFSTEP ? 0.5f : 1.0f; static constexpr int ldc = 1024;
    bf16_t* hb; float* out; float* ssq; PG8_LAS float* xs;
    __device__ __forceinline__ void operator()(const f32x4 (&acc)[2][2][4][2], const Unit& u, int wr, int wc, int fr, int fq) const {
        const int row0 = u.pm * BM + wr * 64 + fr; const int col0 = u.pn * BM + wc * 32 + 8 * fq;
        u32x4 cur[2], nxt[2];
#pragma unroll
        for (int bj = 0; bj < 2; ++bj) cur[bj] = *(const u32x4*)(hb + (size_t)row0 * ldc + col0 + bj * HALF);
#pragma unroll
        for (int i = 0; i < 8; ++i) { const int ai = i >> 2, m = i & 3; const int row = row0 + ai * HALF + m * 16; const size_t off = (size_t)row * ldc + col0; float s = 0.f;
            if (i < 7) { const int rown = row0 + ((i + 1) >> 2) * HALF + ((i + 1) & 3) * 16;
#pragma unroll
                for (int bj = 0; bj < 2; ++bj) nxt[bj] = *(const u32x4*)(hb + (size_t)rown * ldc + col0 + bj * HALF); }
            asm volatile("" ::: "memory");
#pragma unroll
            for (int bj = 0; bj < 2; ++bj) { const u32x4 c = cur[bj]; f32x4 b0, b1;
                b0[0] = __builtin_bit_cast(float, c.x << 16); b0[1] = __builtin_bit_cast(float, c.x & 0xffff0000u); b0[2] = __builtin_bit_cast(float, c.y << 16); b0[3] = __builtin_bit_cast(float, c.y & 0xffff0000u);
                b1[0] = __builtin_bit_cast(float, c.z << 16); b1[1] = __builtin_bit_cast(float, c.z & 0xffff0000u); b1[2] = __builtin_bit_cast(float, c.w << 16); b1[3] = __builtin_bit_cast(float, c.w & 0xffff0000u);
                const f32x4 o0 = b0 + acc[ai][bj][m][0] * alpha, o1 = b1 + acc[ai][bj][m][1] * alpha;
                if (out) { *(f32x4*)(out + off + bj * HALF) = o0; *(f32x4*)(out + off + bj * HALF + 4) = o1; }
                else { u32x4 w; w.x = cvt_pk_bf16(o0[0], o0[1]); w.y = cvt_pk_bf16(o0[2], o0[3]); w.z = cvt_pk_bf16(o1[0], o1[1]); w.w = cvt_pk_bf16(o1[2], o1[3]);
                    *(u32x4*)(hb + off + bj * HALF) = w;
                    const float r0 = __builtin_bit_cast(float, w.x << 16), r1 = __builtin_bit_cast(float, w.x & 0xffff0000u), r2 = __builtin_bit_cast(float, w.y << 16), r3 = __builtin_bit_cast(float, w.y & 0xffff0000u);
                    const float r4 = __builtin_bit_cast(float, w.z << 16), r5 = __builtin_bit_cast(float, w.z & 0xffff0000u), r6 = __builtin_bit_cast(float, w.w << 16), r7 = __builtin_bit_cast(float, w.w & 0xffff0000u);
                    s += ((r0 * r0 + r1 * r1) + (r2 * r2 + r3 * r3)) + ((r4 * r4 + r5 * r5) + (r6 * r6 + r7 * r7)); } }
            if (!out) { s += __shfl_xor(s, 16); s += __shfl_xor(s, 32); if (fq == 0) xs[(ai * HALF + wr * 64 + m * 16 + fr) * 4 + wc] = s; }
            asm volatile("" ::: "memory");
#pragma unroll
            for (int bj = 0; bj < 2; ++bj) cur[bj] = nxt[bj];
        }
        if (!out) {
            asm volatile("s_waitcnt lgkmcnt(0)\n\ts_barrier" ::: "memory");
            int t = threadIdx.x; asm volatile("" : "+v"(t));
            if (t < 256) { const f32x4 v = *(const PG8_LAS f32x4*)(xs + t * 4); ssq[(size_t)(u.pm * BM + t) * 4 + u.pn] = (v[0] + v[1]) + (v[2] + v[3]); }
        }
    }
};

struct EpiHead {
    static constexpr bool PERM = true, AFTER_DRAIN = false;
    bf16_t* O; int ldc; const float* ssq;
    int lo1, hi1, lo2, hi2, lo3, hi3, logf_tile;
    const float *g1, *g2, *g3; float s1, s2, s3;
    const float* bf; float* logf;
    __device__ __forceinline__ void operator()(const f32x4 (&acc)[2][2][4][2], const Unit& u, int wr, int wc, int fr, int fq) const {
        const int row0 = u.pm * BM + wr * 64 + fr; const int pn = u.pn;
        if (pn == logf_tile) {
            if (wc == 0 && fq < 2) {
                float rsv[2][4]; rows_rstd(ssq, row0, rsv);
#pragma unroll
                for (int ai = 0; ai < 2; ++ai)
#pragma unroll
                    for (int m = 0; m < 4; ++m) { const int row = row0 + ai * HALF + m * 16; const float rs = rsv[ai][m]; const int b = row >> 12, t = row & 4095;
#pragma unroll
                        for (int n = 0; n < 2; ++n)
#pragma unroll
                            for (int j = 0; j < 4; ++j) { const int e = 8 * fq + 4 * n + j;
                                if (e < 12) { const float x = acc[ai][0][m][n][j] * rs + bf[e]; const float ls = fminf(x, 0.f) - log1pf(__expf(-fabsf(x))); logf[(size_t)(b * 12 + e) * 4096 + t] = ls; } } }
            }
            return;
        }
        const float* gn = nullptr; float sc = 1.f;
        if (pn >= lo1 && pn < hi1) { gn = g1; sc = s1; } else if (pn >= lo2 && pn < hi2) { gn = g2; sc = s2; } else if (pn >= lo3 && pn < hi3) { gn = g3; sc = s3; }
        f32x4 gv[2][2];
#pragma unroll
        for (int bj = 0; bj < 2; ++bj)
#pragma unroll
            for (int n = 0; n < 2; ++n) { if (gn) { gv[bj][n] = *(const f32x4*)(gn + 32 * bj + 8 * fq + 4 * n) * sc; } else gv[bj][n] = (f32x4){1.f, 1.f, 1.f, 1.f}; }
        const int col0 = pn * BM + wc * 64 + 8 * fq;
        float rsv[2][4]; rows_rstd(ssq, row0, rsv);
#pragma unroll
        for (int ai = 0; ai < 2; ++ai)
#pragma unroll
            for (int m = 0; m < 4; ++m) { const int row = row0 + ai * HALF + m * 16; const float rs = rsv[ai][m];
                f32x4 v[2][2]; float s = 0.f;
#pragma unroll
                for (int bj = 0; bj < 2; ++bj)
#pragma unroll
                    for (int n = 0; n < 2; ++n) { v[bj][n] = acc[ai][bj][m][n] * rs; s += (v[bj][n][0] * v[bj][n][0] + v[bj][n][1] * v[bj][n][1]) + (v[bj][n][2] * v[bj][n][2] + v[bj][n][3] * v[bj][n][3]); }
                float hs = 1.f;
                if (gn) { s += __shfl_xor(s, 16); s += __shfl_xor(s, 32); hs = __builtin_amdgcn_rsqf(s * (1.0f / 64.0f) + NORM_EPS_F); }
#pragma unroll
                for (int bj = 0; bj < 2; ++bj) { const f32x4 a = v[bj][0] * gv[bj][0] * hs, c = v[bj][1] * gv[bj][1] * hs;
                    u32x4 w; w.x = cvt_pk_bf16(a[0], a[1]); w.y = cvt_pk_bf16(a[2], a[3]); w.z = cvt_pk_bf16(c[0], c[1]); w.w = cvt_pk_bf16(c[2], c[3]);
                    *(u32x4*)(O + (size_t)row * ldc + col0 + 32 * bj) = w; }
                asm volatile("" ::: "memory"); }
    }
};

template <class Epi, class Sched, bool ALIGN_EPI = false, bool SP2 = false>
__device__ __forceinline__ void gemm_phase(PG8_LAS unsigned char* lds, const Gemm g, const Sched& S, const Epi& E) {
    int tid_ = threadIdx.x; asm volatile("" : "+v"(tid_)); const int tid = tid_, wid = __builtin_amdgcn_readfirstlane(tid >> 6), lane = tid & 63, wr = wid >> 2, wc = wid & 3, fr = lane & 15, fq = lane >> 4;
    const int K = g.K, nt = K / BK;
    unsigned voffA[2], voffB[2];
#pragma unroll
    for (int i = 0; i < 2; ++i) { int R, C; stage_rc(tid * 16 + i * 8192, R, C); const int Rb = Epi::PERM ? ((R & ~31) + perm32(R & 31)) : R;
        voffA[i] = (unsigned)(R * K + C) * 2u; voffB[i] = (unsigned)(Rb * K + C) * 2u; }
    const size_t kstep = (size_t)(BK * 2);
    const size_t hstep = (size_t)HALF * K * 2;
    const size_t tstep = 2 * hstep;
    const unsigned ldsw = (unsigned)wid * 1024u;
    const int aoff = lds_byte(wr * 64 + fr, fq * 8), boff = lds_byte(wc * 32 + fr, fq * 8);
#define PG8_SA(b, h) (((b) * 2 + (h)) * HTB)
#define PG8_SB(b, h) ((4 + (b) * 2 + (h)) * HTB)
#define PG8_STAGE(bufoff, gbase, voff) do { _Pragma("unroll") for (int _i = 0; _i < 2; ++_i) \
        __builtin_amdgcn_global_load_lds((const unsigned*)((const char*)(gbase) + (voff)[_i]), (PG8_LAS unsigned*)(lds + (bufoff) + ldsw + _i * 8192), 16, 0, 0); } while (0)
#define PG8_LDA(dst, b, h) do { _Pragma("unroll") for (int m = 0; m < 4; ++m) _Pragma("unroll") for (int k = 0; k < 2; ++k) dst[m][k] = *(const PG8_LAS bf16x8*)(lds + PG8_SA(b, h) + aoff + m * 2048 + k * 1024); } while (0)
#define PG8_LDB(dst, b, h) do { _Pragma("unroll") for (int n = 0; n < 2; ++n) _Pragma("unroll") for (int k = 0; k < 2; ++k) dst[n][k] = *(const PG8_LAS bf16x8*)(lds + PG8_SB(b, h) + boff + n * 2048 + k * 1024); } while (0)
#define PG8_MMA(ai, bj, At, Bt) do { __builtin_amdgcn_s_setprio(1); _Pragma("unroll") for (int m = 0; m < 4; ++m) _Pragma("unroll") for (int n = 0; n < 2; ++n) _Pragma("unroll") for (int k = 0; k < 2; ++k) \
        acc[ai][bj][m][n] = __builtin_amdgcn_mfma_f32_16x16x32_bf16(Bt[n][k], At[m][k], acc[ai][bj][m][n], 0, 0, 0); __builtin_amdgcn_s_setprio(0); } while (0)
#define PG8_WAIT_V(n) asm volatile("s_waitcnt vmcnt(" #n ")" ::: "memory")
#define PG8_WAIT_L(n) asm volatile("s_waitcnt lgkmcnt(" #n ")" ::: "memory")
#define PG8_BAR __builtin_amdgcn_s_barrier()
#define PG8_SCHED __builtin_amdgcn_sched_barrier(0)
    Unit cur, nxt; int ui = 0;
    if (!S.next(0, cur)) return;
    f32x4 acc[2][2][4][2];
#pragma unroll
    for (int a = 0; a < 2; ++a)
#pragma unroll
        for (int b = 0; b < 2; ++b)
#pragma unroll
            for (int m = 0; m < 4; ++m)
#pragma unroll
                for (int n = 0; n < 2; ++n) acc[a][b][m][n] = (f32x4){0.f, 0.f, 0.f, 0.f};
    bf16x8 At[4][2], B0[2][2], B1[2][2];
    const char* cA = (const char*)g.A + (size_t)cur.pm * tstep; const char* cB = (const char*)g.Bt + (size_t)cur.pn * tstep;
    S.a_ready(cur);
    if constexpr (SP2) {
        PG8_STAGE(PG8_SB(0, 0), cB, voffB); PG8_STAGE(PG8_SB(0, 1), cB + hstep, voffB); PG8_STAGE(PG8_SA(0, 0), cA, voffA); PG8_STAGE(PG8_SA(0, 1), cA + hstep, voffA);
        if (wr == 1) PG8_BAR;
        PG8_WAIT_V(2); PG8_BAR;
        PG8_STAGE(PG8_SB(1, 0), cB + kstep, voffB); PG8_STAGE(PG8_SA(1, 0), cA + kstep, voffA); PG8_STAGE(PG8_SB(1, 1), cB + hstep + kstep, voffB);
        PG8_WAIT_V(6); PG8_BAR;
    } else {
        PG8_STAGE(PG8_SB(0, 0), cB, voffB); PG8_STAGE(PG8_SA(0, 0), cA, voffA); PG8_STAGE(PG8_SB(0, 1), cB + hstep, voffB); PG8_STAGE(PG8_SA(0, 1), cA + hstep, voffA);
        if (wr == 1) PG8_BAR;
        PG8_WAIT_V(4); PG8_BAR;
        PG8_STAGE(PG8_SB(1, 0), cB + kstep, voffB); PG8_STAGE(PG8_SA(1, 0), cA + kstep, voffA); PG8_STAGE(PG8_SB(1, 1), cB + hstep + kstep, voffB);
        PG8_WAIT_V(6); PG8_BAR;
    }
    for (;;) {
        const bool has_next = S.next(ui + 1, nxt);
        const char* nA = has_next ? (const char*)g.A + (size_t)nxt.pm * tstep : cA; const char* nB = has_next ? (const char*)g.Bt + (size_t)nxt.pn * tstep : cB;
        for (int t = 0; t < nt; t += 2) {
            const bool last = (t == nt - 2);
            const char* a1 = cA + (size_t)(t + 1) * kstep;
            const char* a2 = last ? nA : cA + (size_t)(t + 2) * kstep; const char* b2 = last ? nB : cB + (size_t)(t + 2) * kstep;
            const char* a3 = a2 + kstep; const char* b3 = b2 + kstep;
            if (last && has_next) S.a_ready(nxt);
            if constexpr (SP2) {
            PG8_LDB(B0, 0, 0); PG8_LDB(B1, 0, 1); PG8_SCHED; PG8_LDA(At, 0, 0); PG8_STAGE(PG8_SA(1, 1), a1 + hstep, voffA);
            PG8_WAIT_V(8); PG8_WAIT_L(0); PG8_BAR; PG8_MMA(0, 0, At, B0); PG8_MMA(0, 1, At, B1); PG8_BAR; PG8_SCHED;
            PG8_LDA(At, 0, 1); PG8_STAGE(PG8_SB(0, 0), b2, voffB); PG8_STAGE(PG8_SB(0, 1), b2 + hstep, voffB); PG8_STAGE(PG8_SA(0, 0), a2, voffA);
            PG8_WAIT_V(8); PG8_WAIT_L(0); PG8_BAR; PG8_MMA(1, 0, At, B0); PG8_MMA(1, 1, At, B1); PG8_BAR; PG8_SCHED;
            PG8_LDB(B0, 1, 0); PG8_LDB(B1, 1, 1); PG8_SCHED; PG8_LDA(At, 1, 0); PG8_STAGE(PG8_SA(0, 1), a2 + hstep, voffA);
            PG8_WAIT_V(8); PG8_WAIT_L(0); PG8_BAR; PG8_MMA(0, 0, At, B0); PG8_MMA(0, 1, At, B1); PG8_BAR; PG8_SCHED;
            PG8_LDA(At, 1, 1); PG8_STAGE(PG8_SB(1, 0), b3, voffB); PG8_STAGE(PG8_SB(1, 1), b3 + hstep, voffB); PG8_STAGE(PG8_SA(1, 0), a3, voffA);
            PG8_WAIT_V(8); PG8_WAIT_L(0); PG8_BAR; PG8_MMA(1, 0, At, B0); PG8_MMA(1, 1, At, B1); PG8_BAR; PG8_SCHED;
            } else {
            PG8_LDB(B0, 0, 0); PG8_SCHED; PG8_LDA(At, 0, 0); PG8_STAGE(PG8_SA(1, 1), a1 + hstep, voffA);
            PG8_WAIT_L(8); PG8_BAR; PG8_WAIT_L(0); PG8_MMA(0, 0, At, B0); PG8_BAR; PG8_SCHED;
            PG8_LDB(B1, 0, 1); PG8_STAGE(PG8_SB(0, 0), b2, voffB);
            PG8_BAR; PG8_WAIT_L(0); PG8_MMA(0, 1, At, B1); PG8_BAR;
            PG8_LDA(At, 0, 1); PG8_STAGE(PG8_SA(0, 0), a2, voffA);
            PG8_BAR; PG8_WAIT_L(0); PG8_MMA(1, 0, At, B0); PG8_BAR; PG8_SCHED;
            PG8_STAGE(PG8_SB(0, 1), b2 + hstep, voffB);
            PG8_WAIT_V(6); PG8_BAR; PG8_MMA(1, 1, At, B1); PG8_BAR;
            PG8_LDB(B0, 1, 0); PG8_SCHED; PG8_LDA(At, 1, 0); PG8_STAGE(PG8_SA(0, 1), a2 + hstep, voffA);
            PG8_WAIT_L(8); PG8_BAR; PG8_WAIT_L(0); PG8_MMA(0, 0, At, B0); PG8_BAR; PG8_SCHED;
            PG8_LDB(B1, 1, 1); PG8_STAGE(PG8_SB(1, 0), b3, voffB);
            PG8_BAR; PG8_WAIT_L(0); PG8_MMA(0, 1, At, B1); PG8_BAR;
            PG8_LDA(At, 1, 1); PG8_STAGE(PG8_SA(1, 0), a3, voffA);
            PG8_BAR; PG8_WAIT_L(0); PG8_MMA(1, 0, At, B0); PG8_BAR; PG8_SCHED;
            PG8_STAGE(PG8_SB(1, 1), b3 + hstep, voffB);
            PG8_WAIT_V(6); PG8_BAR; PG8_MMA(1, 1, At, B1); PG8_BAR;
            }
        }
        if constexpr (ALIGN_EPI) { if (wr == 0) PG8_BAR; }
        if constexpr (!Epi::AFTER_DRAIN) { E(acc, cur, wr, wc, fr, fq); S.done(cur); }
        if (!has_next) break;
#pragma unroll
        for (int a = 0; a < 2; ++a)
#pragma unroll
            for (int b = 0; b < 2; ++b)
#pragma unroll
                for (int m = 0; m < 4; ++m)
#pragma unroll
                    for (int n = 0; n < 2; ++n) acc[a][b][m][n] = (f32x4){0.f, 0.f, 0.f, 0.f};
        cur = nxt; cA = nA; cB = nB; ++ui;
        if constexpr (ALIGN_EPI) { if (wr == 1) PG8_BAR; }
    }
    PG8_WAIT_V(0);
    if constexpr (!ALIGN_EPI) { if (wr == 0) PG8_BAR; }
    PG8_BAR;
    if constexpr (Epi::AFTER_DRAIN) { E.fused(acc, cur, wr, wc, fr, fq, lds, wid, lane); S.done(cur); }
#undef PG8_SA
#undef PG8_SB
#undef PG8_STAGE
#undef PG8_LDA
#undef PG8_LDB
#undef PG8_MMA
#undef PG8_WAIT_V
#undef PG8_WAIT_L
#undef PG8_BAR
#undef PG8_SCHED
}
}
#define PG8_SP2 true
#include <hip/hip_bf16.h>
#include <cmath>
namespace attn_body {
using bf16=__hip_bfloat16;
using bf16x8=__attribute__((ext_vector_type(8)))short;
using s16x4=__attribute__((ext_vector_type(4)))short;
using f32x16=__attribute__((ext_vector_type(16)))float;
using u32x4=__attribute__((ext_vector_type(4)))unsigned;
using f32x4v=__attribute__((ext_vector_type(4)))float;
constexpr int SEQ=4096,D=64;
constexpr int NW=8,QBLK=32,QB=QBLK*NW,KVBLK=64,NQB=SEQ/QB;
constexpr int ATTN_UNIT_ROWS=QB;
__device__ __forceinline__ int crow(int r,int hi){return (r&3)+8*(r>>2)+4*hi;}
#define SBAR() __builtin_amdgcn_sched_barrier(0)
__device__ __forceinline__ void cmask(f32x16&p0,f32x16&p1,int jb,int qrel,int hi){
  const float NEG=-INFINITY; int x=qrel-64*jb-4*hi; asm volatile("":"+v"(x));
  #pragma unroll
  for(int r=0;r<16;++r){const int c=(r&3)+8*(r>>2); if(c>x)p0[r]=NEG; if(c+32>x)p1[r]=NEG;}
}

constexpr int NSLOT=3, SLOTB=8192;
constexpr int LDS_K=0, LDS_V=NSLOT*SLOTB, LDS_WS=2*NSLOT*SLOTB, LDS_OST=LDS_WS+NW*64*4, LDS_CK=LDS_OST+NW*4096, LDS_BYTES=LDS_CK+SEQ*4;
constexpr float C2=0.125f*1.4426950408889634f;
__device__ __forceinline__ void glds16(const void*gsrc,unsigned lds_dst){unsigned keep;
  asm volatile("s_mov_b32 %0, m0\n\ts_mov_b32 m0, %2\n\ts_nop 0\n\tglobal_load_lds_dwordx4 %1, off\n\ts_mov_b32 m0, %0":"=&s"(keep):"v"(gsrc),"s"(lds_dst):"memory");}
__device__ __forceinline__ float max3f(float a,float b,float c){float r;asm("v_max3_f32 %0, %1, %2, %3":"=v"(r):"v"(a),"v"(b),"v"(c));return r;}
__device__ __forceinline__ float max2f(float a,float b){float r;asm("v_max_f32_e32 %0, %1, %2":"=v"(r):"v"(a),"v"(b));return r;}
__device__ __forceinline__ float fadd_s(float a,float b){float r;asm("v_add_f32_e32 %0, %1, %2":"=v"(r):"v"(a),"v"(b));return r;}
__device__ __forceinline__ float fsub_s(float a,float b){float r;asm("v_sub_f32_e32 %0, %1, %2":"=v"(r):"v"(a),"v"(b));return r;}
typedef float f32x2_t __attribute__((ext_vector_type(2))); typedef __bf16 bf16x2_t __attribute__((ext_vector_type(2)));
__device__ __forceinline__ unsigned cvtpk_s(float lo,float hi){f32x2_t v={lo,hi};bf16x2_t b=__builtin_convertvector(v,bf16x2_t);return __builtin_bit_cast(unsigned,b);}
#define WAIT_BAR(N) asm volatile("s_waitcnt vmcnt(" #N ") lgkmcnt(0)\n\ts_barrier":::"memory")

__device__ __forceinline__ void qkt(f32x16&p0,f32x16&p1,const char*Kslot,const bf16x8*qr,int r32,int hi){
  const char*kb=Kslot+hi*1024+r32*16;
  #pragma unroll
  for(int d0=0;d0<4;++d0){
    const bf16x8 b0=*reinterpret_cast<const bf16x8*>(kb+d0*2048);
    const bf16x8 b1=*reinterpret_cast<const bf16x8*>(kb+d0*2048+512);
    {p0=__builtin_amdgcn_mfma_f32_32x32x16_bf16(b0,qr[d0],p0,0,0,0);p1=__builtin_amdgcn_mfma_f32_32x32x16_bf16(b1,qr[d0],p1,0,0,0);}}
}
typedef __attribute__((address_space(3))) const char* lds_cptr;
typedef short v4i16_t __attribute__((ext_vector_type(4)));
__device__ __forceinline__ void kload8(bf16x8*kf,lds_cptr kp){
  kf[0]=*(const __attribute__((address_space(3))) bf16x8*)(kp);      kf[1]=*(const __attribute__((address_space(3))) bf16x8*)(kp+512);
  kf[2]=*(const __attribute__((address_space(3))) bf16x8*)(kp+2048); kf[3]=*(const __attribute__((address_space(3))) bf16x8*)(kp+2560);
  kf[4]=*(const __attribute__((address_space(3))) bf16x8*)(kp+4096); kf[5]=*(const __attribute__((address_space(3))) bf16x8*)(kp+4608);
  kf[6]=*(const __attribute__((address_space(3))) bf16x8*)(kp+6144); kf[7]=*(const __attribute__((address_space(3))) bf16x8*)(kp+6656);
}
__device__ __forceinline__ void kload2(bf16x8*kf,lds_cptr kp,int j){ kf[2*j]=*(const __attribute__((address_space(3))) bf16x8*)(kp+j*2048); kf[2*j+1]=*(const __attribute__((address_space(3))) bf16x8*)(kp+j*2048+512); }
__device__ __forceinline__ s16x4 vtr(lds_cptr p){ return __builtin_bit_cast(s16x4,__builtin_amdgcn_ds_read_tr16_b64_v4i16((__attribute__((address_space(3))) v4i16_t*)p)); }
__device__ __forceinline__ float rowmax(const f32x16&p0,const f32x16&p1){
  float a=max3f(p0[0],p0[1],p1[0]),b=max3f(p0[2],p0[3],p1[1]);a=max3f(a,p1[2],p1[3]);
  #pragma unroll
  for(int r=4;r<16;r+=4){a=max3f(a,p0[r],p0[r+1]);b=max3f(b,p0[r+2],p0[r+3]);a=max3f(a,p1[r],p1[r+1]);b=max3f(b,p1[r+2],p1[r+3]);}
  const float m=max2f(a,b);
  auto rr=__builtin_amdgcn_permlane32_swap(__float_as_uint(m),__float_as_uint(m),false,false);
  return max2f(__uint_as_float(rr[0]),__uint_as_float(rr[1]));
}
__device__ __forceinline__ void pv(f32x16*o,int vb,bf16x8 pa0,bf16x8 pa1,bf16x8 pa2,bf16x8 pa3){
  #pragma unroll
  for(int d0=0;d0<2;++d0){s16x4 lo[4],hi[4];
    #pragma unroll
    for(int ks=0;ks<4;++ks){
      asm volatile("ds_read_b64_tr_b16 %0,%1 offset:%c2":"=&v"(lo[ks]):"v"(vb),"i"(d0*4096+ks*1024):"memory");
      asm volatile("ds_read_b64_tr_b16 %0,%1 offset:%c2":"=&v"(hi[ks]):"v"(vb),"i"(d0*4096+ks*1024+512):"memory");}
    asm volatile("s_waitcnt lgkmcnt(0)":::"memory");SBAR();
    #define PK(k) (bf16x8){lo[k][0],lo[k][1],lo[k][2],lo[k][3],hi[k][0],hi[k][1],hi[k][2],hi[k][3]}
    o[d0]=__builtin_amdgcn_mfma_f32_32x32x16_bf16(pa0,PK(0),o[d0],0,0,0);
    o[d0]=__builtin_amdgcn_mfma_f32_32x32x16_bf16(pa1,PK(1),o[d0],0,0,0);
    o[d0]=__builtin_amdgcn_mfma_f32_32x32x16_bf16(pa2,PK(2),o[d0],0,0,0);
    o[d0]=__builtin_amdgcn_mfma_f32_32x32x16_bf16(pa3,PK(3),o[d0],0,0,0);
    #undef PK
  }
}

#ifndef ATTN_STORE16
#define ATTN_STORE16(p,v) (*(u32x4*)(p)=(v))
#endif
template<bool CAUSAL,int THRL> __device__ __forceinline__ void attn_unit(const bf16*Qw0,int qpitch,const bf16*__restrict__ Kh,const bf16*__restrict__ Vh,int kvpitch,bf16*Ow0,int opitch,int NT,const float*ckg,char*shm){
  const int tid=threadIdx.x; int lane_=tid&63; asm volatile("":"+v"(lane_)); const int lane=lane_,r32=lane&31,hi=lane>>5; const int wid=__builtin_amdgcn_readfirstlane(tid>>6);
  const bf16*Qw=Qw0+(long)(wid*QBLK)*qpitch;
  const unsigned lds0=(unsigned)(uintptr_t)shm;
  float*wsf=(float*)(shm+LDS_WS)+wid*64;
  const bf16*ksrc=Kh+(long)lane*kvpitch+wid*8;
  const bf16*vsrc=Vh+(long)(16*(wid&3)+(lane>>2))*kvpitch+(wid>>2)*32+(lane&3)*8;
  const unsigned kdst=lds0+LDS_K+wid*1024, vdst=lds0+LDS_V+wid*1024;
  #define DMA_K(t,slot) glds16(ksrc+(long)(t)*KVBLK*kvpitch,(unsigned)__builtin_amdgcn_readfirstlane(kdst+(slot)))
  #define DMA_V(t,slot) glds16(vsrc+(long)(t)*KVBLK*kvpitch,(unsigned)__builtin_amdgcn_readfirstlane(vdst+(slot)))
  const int vb0=(int)(lds0+LDS_V)+((lane>>4)&1)*32+(lane&3)*8+(4*hi+((lane&15)>>2))*64;
  const char*Kbase=shm+LDS_K; bf16x8 kf[8];
  const lds_cptr shm3=(lds_cptr)shm; const lds_cptr kp0=shm3+LDS_K+hi*1024+r32*16; const lds_cptr vp0=shm3+LDS_V+((lane>>4)&1)*32+(lane&3)*8+(4*hi+((lane&15)>>2))*64;
  DMA_K(0,0);DMA_V(0,0);DMA_K(1,SLOTB);
  bf16x8 qr[4];
  #pragma unroll
  for(int d0=0;d0<4;++d0)qr[d0]=*reinterpret_cast<const bf16x8*>(&Qw[(long)r32*qpitch+d0*16+hi*8]);
  typedef __attribute__((address_space(3))) float lds_f32; typedef __attribute__((address_space(3))) f32x4v lds_f32x4;
  lds_f32* const ckl=(lds_f32*)((lds_cptr)shm+LDS_CK);
  if(CAUSAL){ _Pragma("unroll") for(int i_=0;i_<2;++i_){ const int e4=(tid+512*i_)*4; if(e4<NT*KVBLK){ const f32x4v cv=*(const f32x4v*)(ckg+e4); *(lds_f32x4*)(ckl+e4)=cv; } } }
  float mhat=0.f,l_reg=0.f;f32x16 o[2];o[0]=f32x16{};o[1]=f32x16{};
  #define CINITH(C0,t,OFS) do{ const float nm_=-mhat; if(CAUSAL){ const lds_f32* cp_=ckl+(t)*KVBLK+4*hi+(OFS); \
      _Pragma("unroll") for(int g_=0;g_<4;++g_){ const f32x4v a_=*(const lds_f32x4*)(cp_+8*g_); \
        _Pragma("unroll") for(int j_=0;j_<4;++j_){ C0[4*g_+j_]=nm_-a_[j_]; } } } \
    else { _Pragma("unroll") for(int r_=0;r_<16;++r_){ C0[r_]=nm_; } } }while(0)
  #define CINIT(C0,C1,t) do{ CINITH(C0,t,0); CINITH(C1,t,32); }while(0)
  const int qrel=wid*QBLK+r32;
  #define CMASK(P0,P1,t) do{ if(CAUSAL){int jb_=(t)-(NT-4); if(jb_>=0)cmask(P0,P1,jb_,qrel,hi);} }while(0)
  bool resc=false;
  #define START(P0,P1) do{ const float rm=rowmax(P0,P1); resc=false; \
    { const float dl=rm; mhat=fadd_s(mhat,dl); \
      _Pragma("unroll") for(int r=0;r<16;++r){P0[r]=fsub_s(P0[r],dl);P1[r]=fsub_s(P1[r],dl);} } \
    _Pragma("unroll") for(int r=0;r<16;++r)P0[r]=__builtin_amdgcn_exp2f(P0[r]); }while(0)
  #define RESC() do{ if(resc){ asm volatile("s_waitcnt lgkmcnt(0)":::"memory"); \
      _Pragma("unroll") for(int d_=0;d_<2;++d_) _Pragma("unroll") for(int r=0;r<16;++r)o[d_][r]*=wsf[crow(r,hi)]; } }while(0)
  f32x16 pA0,pA1,pB0,pB1;
  int sl_prev=0,sl_cur=0,sl_next=SLOTB;
  #define ROT() do{sl_prev=sl_cur;sl_cur=sl_next;sl_next=(sl_next==(NSLOT-1)*SLOTB)?0:sl_next+SLOTB;}while(0)
  DMA_K(2,2*SLOTB);
  WAIT_BAR(3);
  CINIT(pA0,pA1,0); qkt(pA0,pA1,Kbase,qr,r32,hi);asm volatile("s_nop 15\n\ts_nop 7":"+v"(pA0),"+v"(pA1));CMASK(pA0,pA1,0);
  START(pA0,pA1);
  _Pragma("unroll") for(int r=0;r<16;++r)pA1[r]=__builtin_amdgcn_exp2f(pA1[r]);
  CINIT(pB0,pB1,1);
  WAIT_BAR(0);
  DMA_K(3,0);DMA_V(1,SLOTB);
  ROT();
  kload8(kf,kp0+sl_cur);
  WAIT_BAR(2);
  s16x4 vlo[8],vhi[8]; u32x4 pw0,pw1,pw2,pw3;
  #define PKW(P,B) cvtpk_s(P[B],P[B+1])
  #define PAF(k) __builtin_bit_cast(bf16x8,pw##k)
  #define VFR(i) (bf16x8){vlo[i][0],vlo[i][1],vlo[i][2],vlo[i][3],vhi[i][0],vhi[i][1],vhi[i][2],vhi[i][3]}
  #define PIN(x) asm volatile("":"+v"(x))
  #define MX3(a,b,c) __builtin_fmaxf(__builtin_fmaxf((a),(b)),(c))
  #define GAPA(MF,A0,A1,A2,A3,W0,W1,PW) do{ MF; sacc+=A0; sacc+=A1; sacc+=A2; sacc+=A3; PIN(sacc); W0; W1; PIN(PW); SBAR(); }while(0)
  #define EX(v) __builtin_amdgcn_exp2f(v)
  #define GAPB(MF,X,B) do{ MF; X[B]=EX(X[B]); X[B+1]=EX(X[B+1]); X[B+2]=EX(X[B+2]); X[B+3]=EX(X[B+3]); PIN(X); SBAR(); }while(0)
  #define VRD(i) do{ vlo[i]=vtr(vp_+(((i)>>2)*4096+((i)&3)*1024)); vhi[i]=vtr(vp_+(((i)>>2)*4096+((i)&3)*1024+512)); }while(0)
  #define KRD(G,j) do{ if(G){ kload2(kf,kp0+sl_next,j); SBAR(); } }while(0)
  #define STEP(C0,C1,P0,P1,t,GK,GV,GL) do{ SBAR(); \
    const lds_cptr vp_=vp0+sl_prev; \
    VRD(0); SBAR(); float sacc=(P0[0]+P0[1]); \
    GAPA(C0=__builtin_amdgcn_mfma_f32_32x32x16_bf16(kf[0],qr[0],C0,0,0,0), P0[2],P0[3],P0[4],P0[5],     pw0[0]=PKW(P0,0), pw0[1]=PKW(P0,2), pw0); \
    VRD(4); SBAR(); GAPA(C1=__builtin_amdgcn_mfma_f32_32x32x16_bf16(kf[1],qr[0],C1,0,0,0), P0[6],P0[7],P0[8],P0[9],     pw0[2]=PKW(P0,4), pw0[3]=PKW(P0,6), pw0); \
    VRD(1); SBAR(); GAPA(C0=__builtin_amdgcn_mfma_f32_32x32x16_bf16(kf[2],qr[1],C0,0,0,0),   P0[10],P0[11],P0[12],P0[13], pw1[0]=PKW(P0,8), pw1[1]=PKW(P0,10), pw1); \
    VRD(5); SBAR(); GAPA(C1=__builtin_amdgcn_mfma_f32_32x32x16_bf16(kf[3],qr[1],C1,0,0,0),   P0[14],P0[15],P1[0],P1[1],   pw1[2]=PKW(P0,12),pw1[3]=PKW(P0,14), pw1); \
    VRD(2); SBAR(); GAPA(C0=__builtin_amdgcn_mfma_f32_32x32x16_bf16(kf[4],qr[2],C0,0,0,0),   P1[2],P1[3],P1[4],P1[5],     pw2[0]=PKW(P1,0), pw2[1]=PKW(P1,2), pw2); \
    VRD(6); SBAR(); GAPA(C1=__builtin_amdgcn_mfma_f32_32x32x16_bf16(kf[5],qr[2],C1,0,0,0),   P1[6],P1[7],P1[8],P1[9],     pw2[2]=PKW(P1,4), pw2[3]=PKW(P1,6), pw2); \
    VRD(3); SBAR(); GAPA(C0=__builtin_amdgcn_mfma_f32_32x32x16_bf16(kf[6],qr[3],C0,0,0,0),   P1[10],P1[11],P1[12],P1[13], pw3[0]=PKW(P1,8), pw3[1]=PKW(P1,10), pw3); \
    VRD(7); SBAR(); GAPA(C1=__builtin_amdgcn_mfma_f32_32x32x16_bf16(kf[7],qr[3],C1,0,0,0),   P1[14],P1[15],0.f,0.f,       pw3[2]=PKW(P1,12),pw3[3]=PKW(P1,14), pw3); \
    l_reg+=sacc; \
    if(GK){DMA_K((t)+3,sl_cur);} if(GV){DMA_V((t)+1,sl_next);} \
    CMASK(C0,C1,t); \
    { float a=MX3(C0[0],C0[1],C1[0]),b=MX3(C0[2],C0[3],C1[1]); a=MX3(a,C1[2],C1[3]); \
      _Pragma("unroll") for(int r=4;r<16;r+=4){a=MX3(a,C0[r],C0[r+1]);b=MX3(b,C0[r+2],C0[r+3]);a=MX3(a,C1[r],C1[r+1]);b=MX3(b,C1[r+2],C1[r+3]);} \
      float rm=__builtin_fmaxf(a,b); { auto rr=__builtin_amdgcn_permlane32_swap(__float_as_uint(rm),__float_as_uint(rm),false,false); rm=__builtin_fmaxf(__uint_as_float(rr[0]),__uint_as_float(rr[1])); } \
      resc=false; \
      if(__builtin_expect(__any(rm>(float)THRL),0)){ const float dl=__builtin_fmaxf(rm,0.f); mhat+=dl; \
        _Pragma("unroll") for(int r=0;r<16;++r){C0[r]-=dl;C1[r]-=dl;} \
        const float f=__builtin_amdgcn_exp2f(-dl); l_reg*=f; if(hi==0)wsf[r32]=f; resc=true; } } \
    SBAR(); \
    GAPB(o[0]=__builtin_amdgcn_mfma_f32_32x32x16_bf16(PAF(0),VFR(0),o[0],0,0,0), C0,0); \
    GAPB(o[1]=__builtin_amdgcn_mfma_f32_32x32x16_bf16(PAF(0),VFR(4),o[1],0,0,0), C0,4); \
    if(GV){ CINITH(P0,(t)+1,0); SBAR(); } \
    KRD(GL,0); GAPB(o[0]=__builtin_amdgcn_mfma_f32_32x32x16_bf16(PAF(1),VFR(1),o[0],0,0,0), C0,8); \
    KRD(GL,1); GAPB(o[1]=__builtin_amdgcn_mfma_f32_32x32x16_bf16(PAF(1),VFR(5),o[1],0,0,0), C0,12); \
    KRD(GL,2); GAPB(o[0]=__builtin_amdgcn_mfma_f32_32x32x16_bf16(PAF(2),VFR(2),o[0],0,0,0), C1,0); \
    KRD(GL,3); GAPB(o[1]=__builtin_amdgcn_mfma_f32_32x32x16_bf16(PAF(2),VFR(6),o[1],0,0,0), C1,4); \
    if(GV){ CINITH(P1,(t)+1,32); SBAR(); } \
    GAPB(o[0]=__builtin_amdgcn_mfma_f32_32x32x16_bf16(PAF(3),VFR(3),o[0],0,0,0), C1,8); \
    GAPB(o[1]=__builtin_amdgcn_mfma_f32_32x32x16_bf16(PAF(3),VFR(7),o[1],0,0,0), C1,12); \
    }while(0)
  int t=1;
  #undef CMASK
  #define CMASK(P0,P1,t) do{}while(0)
  for(;t+5<NT;t+=2){
    STEP(pB0,pB1,pA0,pA1,t,true,true,true);     WAIT_BAR(2); RESC(); ROT();
    STEP(pA0,pA1,pB0,pB1,t+1,true,true,true);   WAIT_BAR(2); RESC(); ROT();
  }
  #undef CMASK
  #define CMASK(P0,P1,t) do{ if(CAUSAL){int jb_=(t)-(NT-4); if(jb_>=0)cmask(P0,P1,jb_,qrel,hi);} }while(0)
  #define ENDW(tt) do{ if((tt)+3<NT){WAIT_BAR(2);} else if((tt)+2<NT){WAIT_BAR(1);} else {WAIT_BAR(0);} }while(0)
  for(;t+1<NT;t+=2){
    STEP(pB0,pB1,pA0,pA1,t,(t+3<NT),(t+1<NT),(t+1<NT));       ENDW(t);   RESC(); ROT();
    STEP(pA0,pA1,pB0,pB1,t+1,(t+4<NT),(t+2<NT),(t+2<NT));     ENDW(t+1); RESC(); ROT();
  }
  STEP(pB0,pB1,pA0,pA1,NT-1,false,false,false); RESC();
  { float sacc=pB0[0]+pB0[1]; _Pragma("unroll") for(int r=2;r<16;++r)sacc+=pB0[r]; _Pragma("unroll") for(int r=0;r<16;++r)sacc+=pB1[r]; l_reg+=sacc;
    pw0=(u32x4){PKW(pB0,0),PKW(pB0,2),PKW(pB0,4),PKW(pB0,6)};pw1=(u32x4){PKW(pB0,8),PKW(pB0,10),PKW(pB0,12),PKW(pB0,14)};pw2=(u32x4){PKW(pB1,0),PKW(pB1,2),PKW(pB1,4),PKW(pB1,6)};pw3=(u32x4){PKW(pB1,8),PKW(pB1,10),PKW(pB1,12),PKW(pB1,14)};
    SBAR(); pv(o,vb0+sl_cur,PAF(0),PAF(1),PAF(2),PAF(3)); }
  #undef PKW
  #undef PAF
  #undef VFR
  #undef PIN
  #undef MX3
  #undef GAPA
  #undef GAPB
  #undef EX
  #undef VRD
  #undef KRD
  #undef STEP
  #undef ENDW
  {auto rr=__builtin_amdgcn_permlane32_swap(__float_as_uint(l_reg),__float_as_uint(l_reg),false,false);l_reg=__uint_as_float(rr[0])+__uint_as_float(rr[1]);}
  if(hi==0)wsf[32+r32]=l_reg;asm volatile("s_waitcnt lgkmcnt(0)":::"memory");
  float rli[16];
  #pragma unroll
  for(int r=0;r<16;++r)rli[r]=__builtin_amdgcn_rcpf(wsf[32+crow(r,hi)]);
  bf16*Ow=Ow0+(long)(wid*QBLK)*opitch;
  { bf16*stg=(bf16*)(shm+LDS_OST)+wid*2048;
    #pragma unroll
    for(int r=0;r<16;++r){const int orow=crow(r,hi);
      #pragma unroll
      for(int d0=0;d0<2;++d0)stg[orow*64+d0*32+r32]=__float2bfloat16(o[d0][r]*rli[r]);}
    asm volatile("s_waitcnt lgkmcnt(0)":::"memory");
    #pragma unroll
    for(int i=0;i<4;++i){const int row=i*8+(lane>>3),ch=lane&7; const u32x4 v=*(const u32x4*)(stg+row*64+ch*8); ATTN_STORE16(Ow+(long)row*opitch+ch*8,v);} }
  asm volatile("s_waitcnt lgkmcnt(0)\n\ts_barrier":::"memory");
  #undef CINIT
  #undef CINITH
  #undef DMA_K
  #undef DMA_V
  #undef CMASK
  #undef START
  #undef RESC
  #undef ROT
}
constexpr int ATTN_LDS_BYTES=LDS_BYTES;
#undef SBAR
#undef WAIT_BAR
}
#include <hip/hip_cooperative_groups.h>
namespace cg = cooperative_groups;

#define GAS __attribute__((address_space(1)))
#define LAS __attribute__((address_space(3)))
typedef unsigned short bf16;
typedef unsigned v4u __attribute__((ext_vector_type(4)));
typedef unsigned v2u __attribute__((ext_vector_type(2)));
typedef float f32x4 __attribute__((ext_vector_type(4)));
typedef float f32x16 __attribute__((ext_vector_type(16)));
typedef short bf16x8 __attribute__((ext_vector_type(8)));

constexpr int NWAVES = 8;
constexpr int BATCH = 8, SEQ = 4096, DM = 1024, M = BATCH * SEQ;
constexpr int NMEM = 256, MROWS = BATCH * NMEM;
constexpr int MIXW = 768, MEMW = 256, DFF = 2816, NH = 12, HD = 64;
constexpr int N_LRU = 2 * MIXW + MEMW;
constexpr int N_FOX_SRC = 3 * MIXW + NH + MEMW;
constexpr int N_FOX_GEMM = 2560;
constexpr int N_FOX = 2816;
constexpr float C2 = 0.125f * 1.4426950408889634f;
constexpr float LOG2E = 1.4426950408889634f;

constexpr size_t MiB = 1u << 20;
constexpr size_t WS_WRG = 1 * MiB, WS_WIG = 1 * MiB + 128 * 1024;
constexpr size_t WS_WKV = 2 * MiB, WS_WOUT0 = 3 * MiB, WS_WOUT1 = 5 * MiB, WS_WLRU = 7 * MiB, WS_WFOX = 11 * MiB;
constexpr size_t WS_W1 = 17 * MiB, W1_BYTES = 11 * MiB;
constexpr size_t WS_W2 = 61 * MiB, W2_BYTES = 5 * MiB + 512 * 1024;
constexpr size_t WS_MEMB = 83 * MiB, WS_MEMKV = 87 * MiB;
constexpr size_t WS_SSQ = 89 * MiB, WS_SSQM = 91 * MiB;
constexpr size_t WS_LOGF = 92 * MiB, WS_CK = 94 * MiB, WS_SUMM = 96 * MiB;
constexpr size_t WS_HB = 98 * MiB, WS_CAT = 162 * MiB, WS_R = 226 * MiB, WS_END = 402 * MiB;
constexpr size_t R_AL = (size_t)M * N_LRU * 2;
static_assert(R_AL + (size_t)M * MIXW * 2 <= 176 * MiB, "R region");

constexpr int RING_BYTES = 131072, LDS_BYTES = 147456, XS_OFF = RING_BYTES, MISC_OFF = RING_BYTES + 8192;
static_assert(attn_body::ATTN_LDS_BYTES <= RING_BYTES, "attention LDS");

__device__ __forceinline__ unsigned f2bf(float f) { unsigned u = __builtin_bit_cast(unsigned, f); return (u + 0x7fffu + ((u >> 16) & 1u)) >> 16; }
__device__ __forceinline__ unsigned pk2(float lo, float hi) { return f2bf(lo) | (f2bf(hi) << 16); }
__device__ __forceinline__ float bf_lo(unsigned w) { return __builtin_bit_cast(float, w << 16); }
__device__ __forceinline__ float bf_hi(unsigned w) { return __builtin_bit_cast(float, w & 0xffff0000u); }
__device__ __forceinline__ float wave_sum(float v) {
#pragma unroll
    for (int o = 1; o < 64; o <<= 1) v += __shfl_xor(v, o);
    return v;
}

typedef GAS unsigned gu32;
#define RLX_AGENT __ATOMIC_RELAXED, __HIP_MEMORY_SCOPE_AGENT
#define XB_TMO      128
#define XB_XCNT(j)  (256  + 64 * (j))
#define XB_XSUB(j)  (1280 + 64 * (j))
#define XB_XGEN(j)  (2304 + 64 * (j))
#define XB_TOP      3328
#define XB_TOPGEN   3392
#define XCD_BAR_WORDS 3456
#define XB_SPIN_CAP (1u << 18)

__device__ __forceinline__ unsigned xb_ld(unsigned* p)              { return __hip_atomic_load(p, __ATOMIC_RELAXED, __HIP_MEMORY_SCOPE_AGENT); }
__device__ __forceinline__ unsigned xb_add(unsigned* p, unsigned v) { return __hip_atomic_fetch_add(p, v, __ATOMIC_RELAXED, __HIP_MEMORY_SCOPE_AGENT); }
__device__ __forceinline__ unsigned xb_xcc_id() { return (unsigned)__builtin_amdgcn_s_getreg((3 << 11) | 20) & 0xFu; }
#define XB_SPIN(cond, bar) do { unsigned _sp = 0; while (cond) { __builtin_amdgcn_s_sleep(1); \
    if ((++_sp & 255u) == 0u) { if (xb_ld(&(bar)[XB_TMO])) break; if (_sp > XB_SPIN_CAP) { atomicAdd(&(bar)[XB_TMO], 1u); break; } } } } while (0)

struct XcdBarrier {
    unsigned* bar; unsigned x;
    volatile LAS unsigned* st;
};

__device__ __forceinline__ XcdBarrier xcd_barrier_post(unsigned* bar, volatile LAS unsigned* st) {
    XcdBarrier b; b.bar = bar; b.x = xb_xcc_id(); b.st = st;
    if (threadIdx.x == 0) (void)xb_add(&bar[XB_XCNT(b.x)], 1u);
    return b;
}
__device__ __forceinline__ void xcd_barrier_complete(unsigned* bar, unsigned x, unsigned& nloc, unsigned& nx) {
    const unsigned G = gridDim.x * gridDim.y * gridDim.z;
    unsigned sum, cnt, mine, sp = 0u;
    for (;;) {
        sum = 0u; cnt = 0u; mine = 0u;
#pragma unroll
        for (unsigned j = 0; j < 16; ++j) { const unsigned c = xb_ld(&bar[XB_XCNT(j)]); sum += c; cnt += (c > 0u) ? 1u : 0u; mine = (j == x) ? c : mine; }
        if (sum == G) break;
        __builtin_amdgcn_s_sleep(1);
        if ((++sp & 255u) == 0u) { if (xb_ld(&bar[XB_TMO])) break; if (sp > XB_SPIN_CAP) { atomicAdd(&bar[XB_TMO], 1u); break; } }
    }
    nloc = mine > 0u ? mine : 1u; nx = cnt > 0u ? cnt : 1u;
}

__device__ __forceinline__ void xcd_barrier(const XcdBarrier& b) {
    asm volatile("s_waitcnt vmcnt(0)" ::: "memory");
    __syncthreads();
    if (threadIdx.x == 0) {
        unsigned* bar = b.bar;
        __builtin_amdgcn_s_waitcnt(0);
        unsigned nloc = b.st[0], nx = b.st[1];
        if (nloc == 0u) { xcd_barrier_complete(bar, b.x, nloc, nx); b.st[0] = nloc; b.st[1] = nx; }
        const unsigned old = xb_add(&bar[XB_XSUB(b.x)], 1u);
        const unsigned gen = old / nloc;
        if (old + 1u == (gen + 1u) * nloc) {
            __builtin_amdgcn_fence(__ATOMIC_RELEASE, "agent");
            asm volatile("s_waitcnt vmcnt(0)" ::: "memory");
            const unsigned og = xb_add(&bar[XB_TOP], 1u);
            const unsigned tg = og / nx;
            if (og + 1u == (tg + 1u) * nx) xb_add(&bar[XB_TOPGEN], 1u);
            else XB_SPIN(xb_ld(&bar[XB_TOPGEN]) == tg, bar);
            __builtin_amdgcn_fence(__ATOMIC_ACQUIRE, "agent");
            xb_add(&bar[XB_XGEN(b.x)], 1u);
            asm volatile("s_waitcnt vmcnt(0)" ::: "memory");
        } else {
            XB_SPIN(xb_ld(&bar[XB_XGEN(b.x)]) == gen, bar);
            __builtin_amdgcn_fence(__ATOMIC_ACQUIRE, "agent");
            asm volatile("s_waitcnt vmcnt(0)" ::: "memory");
        }
    }
    __syncthreads();
}

__device__ __forceinline__ void item_load(const float* W, int Nsrc, const float* g, int src0, int nvalid, int k0, int lane, float (&v)[32]) {
    const int n = lane & 31, kh = lane >> 5; const bool ok = n < nvalid; const float* wp = W + (size_t)(k0 + kh) * Nsrc + src0 + n;
#pragma unroll
    for (int i = 0; i < 32; ++i) v[i] = ok ? wp[(size_t)(2 * i) * Nsrc] : 0.f;
    if (g) {
#pragma unroll
        for (int i = 0; i < 32; ++i) v[i] *= g[k0 + 2 * i + kh]; }
}
__device__ __forceinline__ void item_store(const float (&v)[32], bf16* Bt, int K, int n0, int k0, LAS float* scr, int lane) {
    { const int n = lane & 31, kh = lane >> 5;
#pragma unroll
      for (int i = 0; i < 32; ++i) scr[(2 * i + kh) * 33 + n] = v[i]; }
    asm volatile("s_waitcnt lgkmcnt(0)" ::: "memory");
    const int c = lane & 7;
#pragma unroll
    for (int j = 0; j < 4; ++j) { const int n = (lane >> 3) + 8 * j; const LAS float* s = scr + (8 * c) * 33 + n;
        v4u o; o.x = pk2(s[0 * 33], s[1 * 33]); o.y = pk2(s[2 * 33], s[3 * 33]); o.z = pk2(s[4 * 33], s[5 * 33]); o.w = pk2(s[6 * 33], s[7 * 33]);
        *(v4u*)(Bt + (size_t)(n0 + n) * K + k0 + 8 * c) = o; }
    asm volatile("s_waitcnt lgkmcnt(0)" ::: "memory");
}
__device__ __forceinline__ void granule_map(int mode, int gr, int& src0, int& nvalid) {
    const int n0 = gr * 32; nvalid = 32;
    if (mode == 0) { src0 = n0; return; }
    const int tile = n0 >> 8, L = n0 & 255;
    if (mode == 1) { src0 = (L < 128) ? (128 * tile + L) : (DFF + 128 * tile + (L - 128)); return; }
    const int a = 64 * ((L >> 5) & 3) + 32 * (L >> 7);
    const int lc = 256 * tile + a;
    if (mode == 2) { src0 = lc; return; }
    if (lc < 3 * MIXW) { src0 = lc; return; }
    if (lc < 3 * MIXW + MEMW) { src0 = lc + NH; return; }
    if (lc == 3 * MIXW + MEMW) { src0 = 3 * MIXW; nvalid = NH; return; }
    src0 = 0; nvalid = 0;
}
__device__ __forceinline__ void convert_weight(const float* W, int K, int Nsrc, int Ndst, const float* g, bf16* Bt, int mode, LAS float* scr, int lane, int gw, int NGW) {
    const int nk = K / 64, ngr = Ndst / 32, items = nk * ngr;
    for (int it = gw; it < items; it += 2 * NGW) {
        const int it2 = it + NGW; const bool two = it2 < items;
        const int gr = it % ngr, kb = it / ngr, gr2 = two ? it2 % ngr : gr, kb2 = two ? it2 / ngr : kb;
        int src0, nvalid, src02, nvalid2; granule_map(mode, gr, src0, nvalid); granule_map(mode, gr2, src02, nvalid2);
        float va[32], vb[32];
        item_load(W, Nsrc, g, src0, nvalid, kb * 64, lane, va);
        if (two) item_load(W, Nsrc, g, src02, nvalid2, kb2 * 64, lane, vb);
        item_store(va, Bt, K, gr * 32, kb * 64, scr, lane);
        if (two) item_store(vb, Bt, K, gr2 * 32, kb2 * 64, scr, lane);
    }
}
__device__ __forceinline__ void row_to_bf16_ssq(const float* xrow, bf16* orow, float* ssqrow, int lane) {
    const f32x4* xr = (const f32x4*)xrow + lane; f32x4 v[4]; float s = 0.f;
#pragma unroll
    for (int j = 0; j < 4; ++j) { v[j] = xr[64 * j]; s += (v[j][0] * v[j][0] + v[j][1] * v[j][1]) + (v[j][2] * v[j][2] + v[j][3] * v[j][3]); }
    s = wave_sum(s);
    v2u* o8 = (v2u*)orow + lane;
#pragma unroll
    for (int j = 0; j < 4; ++j) { v2u w; w.x = pk2(v[j][0], v[j][1]); w.y = pk2(v[j][2], v[j][3]); o8[64 * j] = w; }
    if (lane < 4) ssqrow[lane] = (lane == 0) ? s : 0.f;
}

__device__ __forceinline__ void rows4_to_bf16_ssq(const float* x, bf16* o, float* ssq, int m0, int stride, int lane) {
    f32x4 v[4][4];
#pragma unroll
    for (int r = 0; r < 4; ++r)
#pragma unroll
        for (int j = 0; j < 4; ++j) v[r][j] = ((const f32x4*)(x + (size_t)(m0 + r * stride) * DM) + lane)[64 * j];
#pragma unroll
    for (int r = 0; r < 4; ++r) { const int m = m0 + r * stride; float s = 0.f;
#pragma unroll
        for (int j = 0; j < 4; ++j) s += (v[r][j][0] * v[r][j][0] + v[r][j][1] * v[r][j][1]) + (v[r][j][2] * v[r][j][2] + v[r][j][3] * v[r][j][3]);
        s = wave_sum(s);
        v2u* o8 = (v2u*)(o + (size_t)m * DM) + lane;
#pragma unroll
        for (int j = 0; j < 4; ++j) { v2u w; w.x = pk2(v[r][j][0], v[r][j][1]); w.y = pk2(v[r][j][2], v[r][j][3]); o8[64 * j] = w; }
        if (lane < 4) ssq[(size_t)m * 4 + lane] = (lane == 0) ? s : 0.f; }
}

namespace lru {
constexpr int XCS = 68;
constexpr int XC_BYTES = 32 * XCS * 4;
constexpr int OFF_WS = NWAVES * XC_BYTES;
constexpr int OFF_CARRY = OFF_WS + NWAVES * 64 * 2 * 4;
__device__ __forceinline__ int crow(int r, int hi) { return (r & 3) + 8 * (r >> 2) + 4 * hi; }
__device__ __forceinline__ float sigm(float x) { return __builtin_amdgcn_rcpf(1.0f + __builtin_amdgcn_exp2f(-x * LOG2E)); }

__device__ __forceinline__ void unit_a(int b, int h, int c, const bf16* P, const float* conv_w, const float* conv_b, const bf16* WrgT, const bf16* WigT,
                                       const float* b_rg, const float* b_ig, const float* lam, bf16* cat, bf16* AL, float* summ, LAS unsigned char* lds) {
    int tid_ = threadIdx.x; asm volatile("" : "+v"(tid_)); const int tid = tid_, lane = tid & 63, r32 = lane & 31, hi = lane >> 5; const int w = __builtin_amdgcn_readfirstlane(tid >> 6);
    const int t0 = c * 256 + w * 32; const long row0 = (long)b * SEQ + t0;
    LAS float* xc = (LAS float*)(lds + w * XC_BYTES);
    bf16x8 afr[4];
#pragma unroll
    for (int kk = 0; kk < 4; ++kk) {
        const int ch0 = 16 * kk + 8 * hi, gch = h * HD + ch0;
        f32x4 a0 = *(const f32x4*)(conv_b + gch), a1 = *(const f32x4*)(conv_b + gch + 4);
#pragma unroll
        for (int tap = 0; tap < 4; ++tap) {
            const int tt = t0 + r32 - 3 + tap;
            if (tt >= 0) {
                const v4u xv = *(const v4u*)(P + (size_t)(row0 + r32 - 3 + tap) * N_LRU + gch);
                const f32x4 w0 = *(const f32x4*)(conv_w + tap * MIXW + gch), w1 = *(const f32x4*)(conv_w + tap * MIXW + gch + 4);
                a0[0] += w0[0] * bf_lo(xv.x); a0[1] += w0[1] * bf_hi(xv.x); a0[2] += w0[2] * bf_lo(xv.y); a0[3] += w0[3] * bf_hi(xv.y);
                a1[0] += w1[0] * bf_lo(xv.z); a1[1] += w1[1] * bf_hi(xv.z); a1[2] += w1[2] * bf_lo(xv.w); a1[3] += w1[3] * bf_hi(xv.w);
            }
        }
        *(LAS f32x4*)(xc + r32 * XCS + ch0) = a0; *(LAS f32x4*)(xc + r32 * XCS + ch0 + 4) = a1;
        v4u pk; pk.x = pk2(a0[0], a0[1]); pk.y = pk2(a0[2], a0[3]); pk.z = pk2(a1[0], a1[1]); pk.w = pk2(a1[2], a1[3]);
        afr[kk] = __builtin_bit_cast(bf16x8, pk);
    }
    f32x16 acc[2][2];
#pragma unroll
    for (int g = 0; g < 2; ++g)
#pragma unroll
        for (int jt = 0; jt < 2; ++jt) { f32x16 z = {}; const bf16* WT = (g == 0 ? WrgT : WigT) + (size_t)((h * HD + 32 * jt + r32) * HD + 8 * hi);
#pragma unroll
            for (int kk = 0; kk < 4; ++kk) { const bf16x8 bfr = *(const bf16x8*)(WT + 16 * kk); z = __builtin_amdgcn_mfma_f32_32x32x16_bf16(afr[kk], bfr, z, 0, 0, 0); }
            acc[g][jt] = z; }
    asm volatile("s_waitcnt lgkmcnt(0)" ::: "memory"); __builtin_amdgcn_wave_barrier();
#pragma unroll
    for (int jt = 0; jt < 2; ++jt) {
        const int gch = h * HD + 32 * jt + r32;
        const float brg = b_rg[gch], big = b_ig[gch], sp = log1pf(expf(-lam[gch]));
#pragma unroll
        for (int r = 0; r < 16; ++r) {
            const float xcv = xc[crow(r, hi) * XCS + 32 * jt + r32];
            const float rg = sigm(acc[0][jt][r] + brg), ig = sigm(acc[1][jt][r] + big);
            const float la = -8.0f * rg * sp, a = __builtin_amdgcn_exp2f(la * LOG2E);
            const float x2 = 2.0f * la;
            const float em = (x2 > -0.25f) ? x2 * (1.0f + x2 * 0.5f * (1.0f + x2 * (1.0f / 3.0f) * (1.0f + x2 * 0.25f * (1.0f + x2 * 0.2f)))) : (a * a - 1.0f);
            acc[0][jt][r] = a; acc[1][jt][r] = __builtin_sqrtf(fmaxf(-em, 0.f)) * ig * xcv;
        }
    }
    asm volatile("s_waitcnt lgkmcnt(0)" ::: "memory"); __builtin_amdgcn_wave_barrier();
    LAS float* wsA = (LAS float*)(lds + OFF_WS);
#pragma unroll
    for (int jt = 0; jt < 2; ++jt) {
        float AG[4], HG[4];
#pragma unroll
        for (int q = 0; q < 4; ++q) { float A = 1.f, H = 0.f;
#pragma unroll
            for (int i = 0; i < 4; ++i) { const int r = 4 * q + i; const float a = acc[0][jt][r], bx = acc[1][jt][r]; H = a * H + bx; A = A * a; acc[1][jt][r] = H; acc[0][jt][r] = A; }
            AG[q] = A; HG[q] = H; }
        float Ac = 1.f, Hc = 0.f, cinA[4], cinH[4];
#pragma unroll
        for (int q = 0; q < 4; ++q) {
            const float pA = __shfl_xor(AG[q], 32), pH = __shfl_xor(HG[q], 32);
            const float fA = hi ? pA : AG[q], fH = hi ? pH : HG[q], sA = hi ? AG[q] : pA, sH = hi ? HG[q] : pH;
            const float A0 = Ac, H0 = Hc;
            Hc = fA * Hc + fH; Ac = Ac * fA;
            cinA[q] = hi ? Ac : A0; cinH[q] = hi ? Hc : H0;
            Hc = sA * Hc + sH; Ac = Ac * sA;
        }
#pragma unroll
        for (int r = 0; r < 16; ++r) { const int q = r >> 2; acc[1][jt][r] += acc[0][jt][r] * cinH[q]; acc[0][jt][r] *= cinA[q]; }
        if (hi == 0) { wsA[(w * 64 + 32 * jt + r32) * 2 + 0] = Ac; wsA[(w * 64 + 32 * jt + r32) * 2 + 1] = Hc; }
    }
    __syncthreads();
#pragma unroll
    for (int jt = 0; jt < 2; ++jt) {
        const int ch = 32 * jt + r32; float Ain = 1.f, Hin = 0.f, At = 1.f, Ht = 0.f;
#pragma unroll
        for (int w2 = 0; w2 < NWAVES; ++w2) { const float A = wsA[(w2 * 64 + ch) * 2 + 0], H = wsA[(w2 * 64 + ch) * 2 + 1];
            if (w2 == w) { Ain = At; Hin = Ht; }
            Ht = A * Ht + H; At = At * A; }
        if (w == NWAVES - 1 && hi == 0) { float* sp = summ + (size_t)(((b * NH + h) * 16 + c) * 2) * 64; sp[ch] = At; sp[64 + ch] = Ht; }
#pragma unroll
        for (int r = 0; r < 16; ++r) { acc[1][jt][r] += acc[0][jt][r] * Hin; acc[0][jt][r] *= Ain; }
    }
    LAS bf16* stg = (LAS bf16*)xc;
#pragma unroll
    for (int jt = 0; jt < 2; ++jt)
#pragma unroll
        for (int r = 0; r < 16; ++r) { const int tt = crow(r, hi), ch = 32 * jt + r32; stg[tt * 64 + ch] = (bf16)f2bf(acc[1][jt][r]); stg[2048 + tt * 64 + ch] = (bf16)f2bf(acc[0][jt][r]); }
    asm volatile("s_waitcnt lgkmcnt(0)" ::: "memory"); __builtin_amdgcn_wave_barrier();
#pragma unroll
    for (int i = 0; i < 4; ++i) { const int row = i * 8 + (lane >> 3), chk = lane & 7;
        const v4u hv = *(const LAS v4u*)(stg + row * 64 + chk * 8), av = *(const LAS v4u*)(stg + 2048 + row * 64 + chk * 8);
        *(v4u*)(cat + (size_t)(row0 + row) * DM + h * HD + chk * 8) = hv;
        *(v4u*)(AL + (size_t)(row0 + row) * MIXW + h * HD + chk * 8) = av; }
    __syncthreads();
}
__device__ __forceinline__ void unit_b(int b, int h, int c, const bf16* P, const bf16* AL, const float* summ, bf16* cat, LAS unsigned char* lds) {
    int tid_ = threadIdx.x; asm volatile("" : "+v"(tid_)); const int tid = tid_; LAS float* carry = (LAS float*)(lds + OFF_CARRY);
    if (tid < 64) { float Hc = 0.f; const float* sp = summ + (size_t)((b * NH + h) * 16) * 2 * 64;
        for (int c2 = 0; c2 < c; ++c2) { const float A = sp[c2 * 128 + tid], H = sp[c2 * 128 + 64 + tid]; Hc = A * Hc + H; }
        carry[tid] = Hc; }
    __syncthreads();
    const long R0 = (long)b * SEQ + c * 256;
#pragma unroll
    for (int i = 0; i < 4; ++i) { const int idx = tid + 512 * i, row = idx >> 3, chk = idx & 7;
        bf16* cp = cat + (size_t)(R0 + row) * DM + h * HD + chk * 8;
        const v4u hv = *(const v4u*)cp, av = *(const v4u*)(AL + (size_t)(R0 + row) * MIXW + h * HD + chk * 8), gv = *(const v4u*)(P + (size_t)(R0 + row) * N_LRU + MIXW + h * HD + chk * 8);
        const f32x4 c0 = *(const LAS f32x4*)(carry + chk * 8), c1 = *(const LAS f32x4*)(carry + chk * 8 + 4);
        float o[8];
#define LRU_B1(k, hw, aw, gw_, cc) { const float hh = hw + aw * cc; const float gg = gw_; const float u2 = 1.5957691216f * (gg + 0.044715f * gg * gg * gg); o[k] = hh * gg * sigm(u2); }
        LRU_B1(0, bf_lo(hv.x), bf_lo(av.x), bf_lo(gv.x), c0[0]) LRU_B1(1, bf_hi(hv.x), bf_hi(av.x), bf_hi(gv.x), c0[1])
        LRU_B1(2, bf_lo(hv.y), bf_lo(av.y), bf_lo(gv.y), c0[2]) LRU_B1(3, bf_hi(hv.y), bf_hi(av.y), bf_hi(gv.y), c0[3])
        LRU_B1(4, bf_lo(hv.z), bf_lo(av.z), bf_lo(gv.z), c1[0]) LRU_B1(5, bf_hi(hv.z), bf_hi(av.z), bf_hi(gv.z), c1[1])
        LRU_B1(6, bf_lo(hv.w), bf_lo(av.w), bf_lo(gv.w), c1[2]) LRU_B1(7, bf_hi(hv.w), bf_hi(av.w), bf_hi(gv.w), c1[3])
#undef LRU_B1
        v4u ov; ov.x = pk2(o[0], o[1]); ov.y = pk2(o[2], o[3]); ov.z = pk2(o[4], o[5]); ov.w = pk2(o[6], o[7]);
        *(v4u*)cp = ov; }
    __syncthreads();
}
}

__device__ __forceinline__ void fgate_unit(int u, const bf16* hb, const bf16* Wf, const float* ssq, const float* bf, float* logf) {
    int tid_ = threadIdx.x; asm volatile("" : "+v"(tid_)); const int lane = tid_ & 63, r32 = lane & 31, hi = lane >> 5; const int w = __builtin_amdgcn_readfirstlane(tid_ >> 6);
    if (w >= 4) return;
    const int row0 = u * 128 + w * 32;
    const bf16* ap = hb + (size_t)(row0 + r32) * DM + 8 * hi; const bf16* bp = Wf + (size_t)r32 * DM + 8 * hi;
    f32x16 acc = {};
#pragma unroll 8
    for (int kk = 0; kk < 64; ++kk) { const bf16x8 a = *(const bf16x8*)(ap + 16 * kk), b = *(const bf16x8*)(bp + 16 * kk); acc = __builtin_amdgcn_mfma_f32_32x32x16_bf16(a, b, acc, 0, 0, 0); }
    if (r32 < NH) { const float bfe = bf[r32];
#pragma unroll
        for (int r = 0; r < 16; ++r) { const int row = row0 + (r & 3) + 8 * (r >> 2) + 4 * hi; const f32x4 p = *(const f32x4*)(ssq + (size_t)row * 4);
            const float rs = __builtin_amdgcn_rsqf(((p[0] + p[1]) + (p[2] + p[3])) * (1.0f / 1024.0f) + 1e-6f);
            const float x = acc[r] * rs + bfe; const float ls = fminf(x, 0.f) - log1pf(__expf(-fabsf(x)));
            logf[(size_t)((row >> 12) * NH + r32) * SEQ + (row & 4095)] = ls; } }
}

__device__ __forceinline__ void cumsum_unit(const float* logf, float* ck2, int s, LAS unsigned char* lds) {
    int tid_ = threadIdx.x; asm volatile("" : "+v"(tid_)); const int tid = tid_, lane = tid & 63, w = tid >> 6; LAS float* wt = (LAS float*)lds;
    const f32x4* src = (const f32x4*)(logf + (size_t)s * SEQ) + tid * 2; f32x4 a = src[0], b = src[1];
    a[1] += a[0]; a[2] += a[1]; a[3] += a[2]; b[0] += a[3]; b[1] += b[0]; b[2] += b[1]; b[3] += b[2];
    float tot = b[3], inc = tot;
#pragma unroll
    for (int o = 1; o < 64; o <<= 1) { const float t = __shfl_up(inc, o); if (lane >= o) inc += t; }
    if (lane == 63) wt[w] = inc;
    __syncthreads();
    float off = inc - tot;
    for (int w2 = 0; w2 < w; ++w2) off += wt[w2];
    f32x4* dst = (f32x4*)(ck2 + (size_t)s * SEQ) + tid * 2;
    dst[0] = (a + off) * LOG2E; dst[1] = (b + off) * LOG2E;
    __syncthreads();
}

__device__ __forceinline__ const float* inp(int i) { unsigned off = (unsigned)i * 8u; asm volatile("" : "+s"(off));
    return *(const float* const __attribute__((address_space(4)))*)((const __attribute__((address_space(4))) char*)__builtin_amdgcn_kernarg_segment_ptr() + off); }
#define IN_x inp(0)
#define IN_mem inp(1)
#define IN_mem_norm_g inp(2)
#define IN_mem_w_kv inp(3)
#define IN_mem_k_norm_g inp(4)
#define IN_ffn1_norm_g inp(5)
#define IN_ffn1_w_in inp(6)
#define IN_ffn1_w_out inp(7)
#define IN_mix_norm_g inp(8)
#define IN_mix_w_out inp(9)
#define IN_memq_norm_g inp(10)
#define IN_ffn2_norm_g inp(11)
#define IN_ffn2_w_in inp(12)
#define IN_ffn2_w_out inp(13)
#define IN_lru_w_in inp(14)
#define IN_lru_conv_w inp(15)
#define IN_lru_conv_b inp(16)
#define IN_lru_w_rg inp(17)
#define IN_lru_b_rg inp(18)
#define IN_lru_w_ig inp(19)
#define IN_lru_b_ig inp(20)
#define IN_lru_lambda inp(21)
#define IN_fox_w_in inp(22)
#define IN_fox_b_f inp(23)
#define IN_fox_q_norm_g inp(24)
#define IN_fox_k_norm_g inp(25)
#ifndef PROBE_DUP_G1
#define PROBE_DUP_G1 0
#endif
#ifndef PROBE_SYNCS
#define PROBE_SYNCS 0
#endif
#ifndef PROBE_DUP_PRO
#define PROBE_DUP_PRO 0
#endif
#ifndef PROBE_DUP_MIX0
#define PROBE_DUP_MIX0 0
#endif
#ifndef PROBE_DUP_MIX
#define PROBE_DUP_MIX 0
#endif
struct Args { const float* in[26]; float* out; unsigned char* ws; };
#define PHASE_BEGIN int bxl = blockIdx.x, Gl = gridDim.x; asm volatile("" : "+s"(bxl), "+s"(Gl)); const int vcul = (Gl % 8 == 0) ? (bxl % 8) * (Gl / 8) + bxl / 8 : bxl; unsigned char* const wsl = (unsigned char*)inp(27); (void)vcul; (void)wsl
#define WSP(T, off) ((T*)(wsl + (off)))
__global__ void __launch_bounds__(NWAVES * 64, 2) mega_fwd(Args args) {
    extern __shared__ __attribute__((aligned(16))) unsigned char lds[];
    cg::grid_group grid = cg::this_grid();
    LAS unsigned char* L = (LAS unsigned char*)lds;
    {
        PHASE_BEGIN; const int tid = threadIdx.x;
        if (bxl == 0) for (int i = tid; i < XCD_BAR_WORDS; i += NWAVES * 64) ((unsigned*)wsl)[i] = 0u;
        if (tid < 2) ((volatile LAS unsigned*)(L + MISC_OFF))[tid] = 0u;
        __syncthreads();
    }
    for (int rep_ = 0; rep_ < 1 + PROBE_DUP_PRO; ++rep_) {
        PHASE_BEGIN; int tid_ = threadIdx.x; asm volatile("" : "+v"(tid_)); const int lane = tid_ & 63, wave = __builtin_amdgcn_readfirstlane(tid_ >> 6);
        LAS float* scr = (LAS float*)(L + wave * 16384);
        const int gw = vcul * NWAVES + wave, NGW = Gl * NWAVES;
#pragma unroll 1
        for (int s = 0; s < 4; ++s) { const int l = s >> 1, f = s & 1;
            const float* win = (f ? IN_ffn2_w_in : IN_ffn1_w_in) + (size_t)l * DM * 2 * DFF; const float* wout = (f ? IN_ffn2_w_out : IN_ffn1_w_out) + (size_t)l * DFF * DM; const float* g = (f ? IN_ffn2_norm_g : IN_ffn1_norm_g) + l * DM;
            convert_weight(win, DM, 2 * DFF, 2 * DFF, g, (bf16*)(wsl + WS_W1 + s * W1_BYTES), 1, scr, lane, gw, NGW);
            convert_weight(wout, DFF, DM, DM, nullptr, (bf16*)(wsl + WS_W2 + s * W2_BYTES), 0, scr, lane, gw, NGW); }
        convert_weight(IN_lru_w_in, DM, N_LRU, N_LRU, IN_mix_norm_g, WSP(bf16, WS_WLRU), 2, scr, lane, gw, NGW);
        convert_weight(IN_fox_w_in, DM, N_FOX_SRC, N_FOX, IN_mix_norm_g + DM, WSP(bf16, WS_WFOX), 3, scr, lane, gw, NGW);
        convert_weight(IN_mix_w_out, DM, DM, DM, nullptr, WSP(bf16, WS_WOUT0), 0, scr, lane, gw, NGW);
        convert_weight(IN_mix_w_out + (size_t)DM * DM, DM, DM, DM, nullptr, WSP(bf16, WS_WOUT1), 0, scr, lane, gw, NGW);
        convert_weight(IN_mem_w_kv, DM, 2 * MEMW, 2 * MEMW, IN_mem_norm_g, WSP(bf16, WS_WKV), 2, scr, lane, gw, NGW);
        { const float* wrg = IN_lru_w_rg; const float* wig = IN_lru_w_ig; bf16* WrgT = WSP(bf16, WS_WRG); bf16* WigT = WSP(bf16, WS_WIG);
          for (int e = gw * 64 + lane; e < NH * HD * HD; e += NGW * 64) { const int hh = e / (HD * HD), j = (e / HD) % HD, i = e % HD;
            WrgT[e] = (bf16)f2bf(wrg[(hh * HD + i) * HD + j]); WigT[e] = (bf16)f2bf(wig[(hh * HD + i) * HD + j]); } }
        { const float* x = IN_x; bf16* hb = WSP(bf16, WS_HB); float* ssq = WSP(float, WS_SSQ);
          int m = gw;
          for (; m + 3 * NGW < M; m += 4 * NGW) rows4_to_bf16_ssq(x, hb, ssq, m, NGW, lane);
          for (; m < M; m += NGW) row_to_bf16_ssq(x + (size_t)m * DM, hb + (size_t)m * DM, ssq + (size_t)m * 4, lane); }
        { const float* mem = IN_mem; bf16* memb = WSP(bf16, WS_MEMB); float* ssqm = WSP(float, WS_SSQM);
          for (int m = gw; m < MROWS; m += NGW) row_to_bf16_ssq(mem + (size_t)m * DM, memb + (size_t)m * DM, ssqm + (size_t)m * 4, lane); }
    }
    grid.sync();
    const XcdBarrier bar = xcd_barrier_post((unsigned*)inp(27), (volatile LAS unsigned*)(L + MISC_OFF));

#pragma unroll 1
    for (int layer_ = 0; layer_ < 2; ++layer_) {
#pragma unroll 1
        for (int f_ = 0; f_ < 2; ++f_) {
            int layer = layer_, f = f_; asm volatile("" : "+s"(layer), "+s"(f));
            if (f == 1) {
                { PHASE_BEGIN;
                  pg8::Gemm g{WSP(bf16, WS_HB), layer ? WSP(bf16, WS_WFOX) : WSP(bf16, WS_WLRU), M, layer ? N_FOX_GEMM : N_LRU, DM}; pg8::StaticOrder S; S.init(M, layer ? N_FOX_GEMM : N_LRU, Gl, bxl);
                  const float* mq = IN_memq_norm_g;
                  pg8::EpiHead E = layer ? pg8::EpiHead{WSP(bf16, WS_R), N_FOX, WSP(float, WS_SSQ), 0, 3, 3, 6, 9, 10, -1, IN_fox_q_norm_g, IN_fox_k_norm_g, mq + HD, C2, 1.f, C2, nullptr, nullptr}
                                         : pg8::EpiHead{WSP(bf16, WS_R), N_LRU, WSP(float, WS_SSQ), 6, 7, 0, 0, 0, 0, -1, mq, nullptr, nullptr, C2, 1.f, 1.f, nullptr, nullptr};
                  pg8::gemm_phase<pg8::EpiHead, pg8::StaticOrder, true, true>(L, g, S, E); }
                if (layer == 0) {
                  PHASE_BEGIN; const int nfull = (M / 256 * (N_LRU / 256)) % Gl; const bool spread = (nfull > 0 && Gl - nfull >= 16);
                  const int c = spread ? ((bxl >= nfull && bxl < nfull + 16) ? bxl - nfull : (1 << 28)) : bxl;
                  pg8::Gemm g{WSP(bf16, WS_MEMB), WSP(bf16, WS_WKV), MROWS, 2 * MEMW, DM}; pg8::StaticOrder S; S.init(MROWS, 2 * MEMW, spread ? 16 : Gl, c);
                  pg8::EpiHead E{WSP(bf16, WS_MEMKV), 2 * MEMW, WSP(float, WS_SSQM), 0, 1, 0, 0, 0, 0, -1, IN_mem_k_norm_g, nullptr, nullptr, 1.f, 1.f, 1.f, nullptr, nullptr};
                  pg8::gemm_phase<pg8::EpiHead, pg8::StaticOrder, true, true>(L, g, S, E); }
                if (layer) { PHASE_BEGIN;
                  for (int u = vcul; u < M / 128; u += Gl) fgate_unit(u, WSP(bf16, WS_HB), WSP(bf16, WS_WFOX) + (size_t)N_FOX_GEMM * DM, WSP(float, WS_SSQ), IN_fox_b_f, WSP(float, WS_LOGF)); }
                xcd_barrier(bar);
                if (layer == 0) {
                    for (int rep_ = 0; rep_ < 1 + PROBE_DUP_MIX + PROBE_DUP_MIX0; ++rep_) {
                    { PHASE_BEGIN;
                      for (int u = vcul; u < BATCH * NH * 16; u += Gl) { const int c = u & 15, bh = u >> 4;
                        lru::unit_a(bh / NH, bh % NH, c, WSP(bf16, WS_R), IN_lru_conv_w, IN_lru_conv_b, WSP(bf16, WS_WRG), WSP(bf16, WS_WIG), IN_lru_b_rg, IN_lru_b_ig, IN_lru_lambda, WSP(bf16, WS_CAT), WSP(bf16, WS_R + R_AL), WSP(float, WS_SUMM), L); } }
                    { PHASE_BEGIN; bf16* R = WSP(bf16, WS_R); bf16* memKV = WSP(bf16, WS_MEMKV); bf16* cat = WSP(bf16, WS_CAT);
                      for (int u = vcul; u < BATCH * 4 * 16; u += Gl) { const int b = u >> 6, hm = (u >> 4) & 3, qb = u & 15;
                        attn_body::attn_unit<false, 24>((const attn_body::bf16*)(R + (size_t)(b * SEQ + qb * 256) * N_LRU + 2 * MIXW + hm * HD), N_LRU,
                            (const attn_body::bf16*)(memKV + (size_t)(b * NMEM) * 2 * MEMW + hm * HD), (const attn_body::bf16*)(memKV + (size_t)(b * NMEM) * 2 * MEMW + MEMW + hm * HD), 2 * MEMW,
                            (attn_body::bf16*)(cat + (size_t)(b * SEQ + qb * 256) * DM + MIXW + hm * HD), DM, 4, nullptr, (char*)lds); } }
                    }
                    xcd_barrier(bar);
                    { PHASE_BEGIN;
                      for (int u = vcul; u < BATCH * NH * 16; u += Gl) { const int c = u & 15, bh = u >> 4; lru::unit_b(bh / NH, bh % NH, c, WSP(bf16, WS_R), WSP(bf16, WS_R + R_AL), WSP(float, WS_SUMM), WSP(bf16, WS_CAT), L); } }
                    xcd_barrier(bar);
                } else {
                    { PHASE_BEGIN; for (int s = bxl; s < BATCH * NH; s += Gl) cumsum_unit(WSP(float, WS_LOGF), WSP(float, WS_CK), s, L); }
                    xcd_barrier(bar);
                    for (int rep_ = 0; rep_ < 1 + PROBE_DUP_MIX; ++rep_) {
                    { PHASE_BEGIN; bf16* R = WSP(bf16, WS_R); bf16* cat = WSP(bf16, WS_CAT); const float* ck2 = WSP(float, WS_CK);
                      for (int p = vcul; p < BATCH * NH * 8; p += Gl) { const int bh = p >> 3, s = p & 7, b = bh / NH, h = bh % NH;
#pragma unroll 1
                        for (int k = 0; k < 2; ++k) { const int qb = k ? 15 - s : s;
                            attn_body::attn_unit<true, 24>((const attn_body::bf16*)(R + (size_t)(b * SEQ + qb * 256) * N_FOX + h * HD), N_FOX,
                                (const attn_body::bf16*)(R + (size_t)(b * SEQ) * N_FOX + MIXW + h * HD), (const attn_body::bf16*)(R + (size_t)(b * SEQ) * N_FOX + 2 * MIXW + h * HD), N_FOX,
                                (attn_body::bf16*)(cat + (size_t)(b * SEQ + qb * 256) * DM + h * HD), DM, 4 * qb + 4, ck2 + (size_t)bh * SEQ, (char*)lds); } } }
                    { PHASE_BEGIN; bf16* R = WSP(bf16, WS_R); bf16* memKV = WSP(bf16, WS_MEMKV); bf16* cat = WSP(bf16, WS_CAT);
                      for (int u = vcul; u < BATCH * 4 * 16; u += Gl) { const int b = u >> 6, hm = (u >> 4) & 3, qb = u & 15;
                        attn_body::attn_unit<false, 24>((const attn_body::bf16*)(R + (size_t)(b * SEQ + qb * 256) * N_FOX + 3 * MIXW + hm * HD), N_FOX,
                            (const attn_body::bf16*)(memKV + (size_t)(b * NMEM) * 2 * MEMW + hm * HD), (const attn_body::bf16*)(memKV + (size_t)(b * NMEM) * 2 * MEMW + MEMW + hm * HD), 2 * MEMW,
                            (attn_body::bf16*)(cat + (size_t)(b * SEQ + qb * 256) * DM + MIXW + hm * HD), DM, 4, nullptr, (char*)lds); } }
                    }
                    xcd_barrier(bar);
                }
                { PHASE_BEGIN;
                  pg8::Gemm g{WSP(bf16, WS_CAT), (const bf16*)(wsl + (layer ? WS_WOUT1 : WS_WOUT0)), M, DM, DM}; pg8::StaticOrder S; S.init(M, DM, Gl, bxl);
                  pg8::EpiRes<false> E{WSP(bf16, WS_HB), nullptr, WSP(float, WS_SSQ), (LAS float*)(L + XS_OFF)};
                  pg8::gemm_phase<pg8::EpiRes<false>, pg8::StaticOrder, true, true>(L, g, S, E); }
                xcd_barrier(bar);
            }
            const int s = layer * 2 + f;
            { PHASE_BEGIN;
              pg8::Gemm g{WSP(bf16, WS_HB), (const bf16*)(wsl + WS_W1 + s * W1_BYTES), M, 2 * DFF, DM}; pg8::StaticOrder S; S.init(M, 2 * DFF, Gl, bxl);
              pg8::EpiSwiglu E{WSP(bf16, WS_R), WSP(float, WS_SSQ)};
              for (int rep_ = 0; rep_ < 1 + PROBE_DUP_G1; ++rep_) { pg8::gemm_phase<pg8::EpiSwiglu, pg8::StaticOrder, true, true>(L, g, S, E); if (PROBE_DUP_G1) xcd_barrier(bar); } }
            xcd_barrier(bar);
            for (int rep_ = 0; rep_ < PROBE_SYNCS; ++rep_) xcd_barrier(bar);
            { PHASE_BEGIN; float* out = (float*)inp(26);
              pg8::Gemm g{WSP(bf16, WS_R), (const bf16*)(wsl + WS_W2 + s * W2_BYTES), M, DM, DFF}; pg8::StaticOrder S; S.init(M, DM, Gl, bxl);
              const bool last = (s == 3);
              pg8::EpiRes<true> E{WSP(bf16, WS_HB), last ? out : nullptr, WSP(float, WS_SSQ), (LAS float*)(L + XS_OFF)};
              pg8::gemm_phase<pg8::EpiRes<true>, pg8::StaticOrder, true, true>(L, g, S, E); }
            if (s != 3) xcd_barrier(bar);
        }
    }
}

extern "C" void kernel_launch(void* const* d_in, const int* in_sizes, int n_in, void* d_out, int out_size, void* d_ws, size_t ws_size, hipStream_t stream) {
    static int grid = 0;
    if (grid == 0) {
        if (n_in != 26 || in_sizes[0] != M * DM || out_size != M * DM || ws_size < WS_END) { fprintf(stderr, "kernel_launch: unexpected shapes (n_in %d, in0 %d, out %d, ws %zu)\n", n_in, n_in > 0 ? in_sizes[0] : -1, out_size, ws_size); grid = -1; return; }
        int dev = 0, cus = 0, per_cu = 0;
        if (hipGetDevice(&dev) != hipSuccess || hipDeviceGetAttribute(&cus, hipDeviceAttributeMultiprocessorCount, dev) != hipSuccess) { grid = -1; return; }
        if (hipFuncSetAttribute((const void*)mega_fwd, hipFuncAttributeMaxDynamicSharedMemorySize, LDS_BYTES) != hipSuccess) { fprintf(stderr, "kernel_launch: hipFuncSetAttribute failed\n"); grid = -1; return; }
        if (hipOccupancyMaxActiveBlocksPerMultiprocessor(&per_cu, (const void*)mega_fwd, NWAVES * 64, LDS_BYTES) != hipSuccess || per_cu < 1) { fprintf(stderr, "kernel_launch: occupancy query says %d\n", per_cu); per_cu = 1; }
        (void)hipGetLastError();
        grid = cus * 1;
    }
    if (grid < 0) return;
    Args a{};
    for (int i = 0; i < 26; ++i) a.in[i] = (const float*)d_in[i];
    a.out = (float*)d_out; a.ws = (unsigned char*)d_ws;
    void* params[] = {&a};
    hipError_t e = hipLaunchCooperativeKernel((const void*)mega_fwd, dim3(grid), dim3(NWAVES * 64), params, LDS_BYTES, stream);
    if (e != hipSuccess) fprintf(stderr, "kernel_launch: cooperative launch failed: %s (grid %d)\n", hipGetErrorString(e), grid);
}
```

```cpp
#include <hip/hip_runtime.h>
#include <cstdio>
#include <cstdint>
namespace pg8 {
#define PG8_LAS __attribute__((address_space(3)))
typedef unsigned short bf16_t;
typedef short bf16x8 __attribute__((ext_vector_type(8)));
typedef float f32x4 __attribute__((ext_vector_type(4)));
typedef unsigned u32x4 __attribute__((ext_vector_type(4)));
constexpr int BM = 256, BK = 64, HALF = 128, HTB = HALF * BK * 2  , STAGE_BYTES = 8 * HTB, NXCD = 8, WGM = 8;

__host__ __device__ __forceinline__ int lds_byte(int r, int c) { const int st = (r >> 4) * 2 + (c >> 5), rr = r & 15, cc = c & 31, ob = rr * 64 + cc * 2; return st * 1024 + (ob ^ (((ob >> 9) & 1) << 5)); }
__host__ __device__ __forceinline__ void stage_rc(int b, int& R, int& C) { const int st = b / 1024, sb = b % 1024, swz = sb ^ (((sb >> 9) & 1) << 5); R = (st >> 1) * 16 + swz / 64; C = (st & 1) * 32 + (swz % 64) / 2; }
__host__ __device__ __forceinline__ int perm32(int rho) { const int n = rho >> 4, i = rho & 15; return 8 * (i >> 2) + 4 * n + (i & 3); }

struct Unit { int pm, pn; };
struct Gemm { const bf16_t* A; const bf16_t* Bt; int M, N, K; int pmask = -1, nmask = -1; unsigned* dummy = nullptr; };

struct StaticOrder {
    int nM, nN, nwg, G, c;
    __host__ __device__ void init(int M, int N, int G_, int c_) { nM = M / BM; nN = N / BM; nwg = nM * nN; G = G_; c = c_; }
    __host__ __device__ bool next(int i, Unit& u) const {
        const long L = (long)i * G + c; if (L >= nwg) return false;
        int wgid = (int)L; { const int q = nwg / NXCD, r = nwg % NXCD, xcd = wgid % NXCD, off = wgid / NXCD; wgid = (xcd < r ? xcd * (q + 1) : r * (q + 1) + (xcd - r) * q) + off; }
        const int nig = WGM * nN, gid = wgid / nig, fm = gid * WGM, gsz = (nM - fm) < WGM ? (nM - fm) : WGM;
        u.pm = fm + ((wgid % nig) % gsz); u.pn = (wgid % nig) / gsz; return true;
    }
    __device__ __forceinline__ void a_ready(const Unit&, int) const {}
    __device__ __forceinline__ void a_commit(int) const {}
    __device__ __forceinline__ void done(const Unit&) const {}
};

typedef float f32x2_cv __attribute__((ext_vector_type(2))); typedef __bf16 bf16x2_cv __attribute__((ext_vector_type(2)));
__device__ __forceinline__ unsigned cvt_pk_bf16(float lo, float hi) { f32x2_cv v = {lo, hi}; bf16x2_cv b = __builtin_convertvector(v, bf16x2_cv); return __builtin_bit_cast(unsigned, b); }
typedef float f32x2 __attribute__((ext_vector_type(2)));
#ifndef PROBE_NO_RELAX
#define PROBE_NO_RELAX 0
#endif
constexpr float NORM_EPS_F = 1e-6f;
constexpr float LOG2E_F = 1.4426950408889634f;
struct RstdOrder : StaticOrder {
    const float* ssq; PG8_LAS float* tab; mutable f32x4 pend;
    __device__ __forceinline__ void a_ready(const Unit& u, int) const { int t = threadIdx.x; asm volatile("" : "+v"(t)); if (t < 256) pend = *(const f32x4*)(ssq + (size_t)(u.pm * BM + t) * 4); }
    __device__ __forceinline__ void a_commit(int ui) const { int t = threadIdx.x; asm volatile("" : "+v"(t));
        if (t < 256) tab[(ui & 1) * 256 + t] = __builtin_amdgcn_rsqf(((pend[0] + pend[1]) + (pend[2] + pend[3])) * (1.0f / 1024.0f) + NORM_EPS_F); }
};
__device__ __forceinline__ void rows_rstd_lds(const PG8_LAS float* tab, int ui, int rl0, float (&rs)[2][4]) {
#pragma unroll
    for (int ai = 0; ai < 2; ++ai)
#pragma unroll
        for (int m = 0; m < 4; ++m) rs[ai][m] = tab[(ui & 1) * 256 + ai * HALF + m * 16 + rl0];
}
__device__ __forceinline__ void rows_rstd(const float* ssq, int row0, float (&rs)[2][4]) {
    f32x4 p[2][4];
#pragma unroll
    for (int ai = 0; ai < 2; ++ai)
#pragma unroll
        for (int m = 0; m < 4; ++m) p[ai][m] = *(const f32x4*)(ssq + (size_t)(row0 + ai * HALF + m * 16) * 4);
#pragma unroll
    for (int ai = 0; ai < 2; ++ai)
#pragma unroll
        for (int m = 0; m < 4; ++m) rs[ai][m] = __builtin_amdgcn_rsqf(((p[ai][m][0] + p[ai][m][1]) + (p[ai][m][2] + p[ai][m][3])) * (1.0f / 1024.0f) + NORM_EPS_F);
    asm volatile("" ::: "memory");
}
__device__ __forceinline__ float fast_sigmoid(float x) { return __builtin_amdgcn_rcpf(1.0f + __builtin_amdgcn_exp2f(-x * LOG2E_F)); }

struct EpiSwiglu {
    static constexpr bool PERM = true, AFTER_DRAIN = false; static constexpr int ldc = 2816; static constexpr int NSTORES = PROBE_NO_RELAX ? 0 : 8;
    bf16_t* O; const PG8_LAS float* tab;
    __device__ __forceinline__ void operator()(const f32x4 (&acc)[2][2][4][2], const Unit& u, int wr, int wc, int fr, int fq, int ui) const {
        const int row0 = u.pm * BM + wr * 64 + fr; const int col0 = u.pn * HALF + wc * 32 + 8 * fq;
        float rsv[2][4]; rows_rstd_lds(tab, ui, wr * 64 + fr, rsv);
#pragma unroll
        for (int ai = 0; ai < 2; ++ai)
#pragma unroll
            for (int m = 0; m < 4; ++m) { const int row = row0 + ai * HALF + m * 16; const float rs = rsv[ai][m];
                const float c1 = -rs * LOG2E_F, c2 = rs * rs;
                const f32x4 g0 = acc[ai][0][m][0], g1 = acc[ai][0][m][1], u0 = acc[ai][1][m][0], u1 = acc[ai][1][m][1];
                f32x4 t0 = g0 * c1, t1 = g1 * c1, p0 = (g0 * u0) * c2, p1 = (g1 * u1) * c2;
#pragma unroll
                for (int j = 0; j < 4; ++j) { t0[j] = __builtin_amdgcn_exp2f(t0[j]); t1[j] = __builtin_amdgcn_exp2f(t1[j]); }
                t0 = t0 + 1.0f; t1 = t1 + 1.0f;
#pragma unroll
                for (int j = 0; j < 4; ++j) { t0[j] = __builtin_amdgcn_rcpf(t0[j]); t1[j] = __builtin_amdgcn_rcpf(t1[j]); }
                const f32x4 v0 = p0 * t0, v1 = p1 * t1;
                u32x4 w; w.x = cvt_pk_bf16(v0[0], v0[1]); w.y = cvt_pk_bf16(v0[2], v0[3]); w.z = cvt_pk_bf16(v1[0], v1[1]); w.w = cvt_pk_bf16(v1[2], v1[3]);
                *(u32x4*)(O + (size_t)row * ldc + col0) = w; asm volatile("" ::: "memory"); }
    }
};

#ifndef PROBE_NO_STORE
#define PROBE_NO_STORE 0
#endif
struct EpiPlain {
    static constexpr bool PERM = true, AFTER_DRAIN = false; static constexpr int ldc = 2816; static constexpr int NSTORES = 0;
    bf16_t* O;
    __device__ __forceinline__ void operator()(const f32x4 (&acc)[2][2][4][2], const Unit& u, int wr, int wc, int fr, int fq, int) const {
        const int row0 = u.pm * BM + wr * 64 + fr; const int col0 = u.pn * HALF + wc * 32 + 8 * fq;
#pragma unroll
        for (int ai = 0; ai < 2; ++ai)
#pragma unroll
            for (int m = 0; m < 4; ++m) { const int row = row0 + ai * HALF + m * 16; const f32x4 v0 = acc[ai][0][m][0] + acc[ai][1][m][0], v1 = acc[ai][0][m][1] + acc[ai][1][m][1];
                u32x4 w; w.x = cvt_pk_bf16(v0[0], v0[1]); w.y = cvt_pk_bf16(v0[2], v0[3]); w.z = cvt_pk_bf16(v1[0], v1[1]); w.w = cvt_pk_bf16(v1[2], v1[3]);
                if (!PROBE_NO_STORE || (w.x == 0x12345678u && w.y == 0x9abcdef0u)) *(u32x4*)(O + (size_t)row * ldc + col0) = w; }
    }
};
template <bool HALFSTEP> struct EpiRes {
    static constexpr bool PERM = true, AFTER_DRAIN = false; static constexpr float alpha = HALFSTEP ? 0.5f : 1.0f; static constexpr int ldc = 1024; static constexpr int NSTORES = 0;
    bf16_t* hb; float* out; float* ssq; PG8_LAS float* xs;
    __device__ __forceinline__ void operator()(const f32x4 (&acc)[2][2][4][2], const Unit& u, int wr, int wc, int fr, int fq, int) const {
        const int row0 = u.pm * BM + wr * 64 + fr; const int col0 = u.pn * BM + wc * 32 + 8 * fq;
        u32x4 cur[2], nxt[2];
#pragma unroll
        for (int bj = 0; bj < 2; ++bj) cur[bj] = *(const u32x4*)(hb + (size_t)row0 * ldc + col0 + bj * HALF);
#pragma unroll
        for (int i = 0; i < 8; ++i) { const int ai = i >> 2, m = i & 3; const int row = row0 + ai * HALF + m * 16; const size_t off = (size_t)row * ldc + col0; float s = 0.f;
            if (i < 7) { const int rown = row0 + ((i + 1) >> 2) * HALF + ((i + 1) & 3) * 16;
#pragma unroll
                for (int bj = 0; bj < 2; ++bj) nxt[bj] = *(const u32x4*)(hb + (size_t)rown * ldc + col0 + bj * HALF); }
            asm volatile("" ::: "memory");
#pragma unroll
            for (int bj = 0; bj < 2; ++bj) { const u32x4 c = cur[bj]; f32x4 b0, b1;
                b0[0] = __builtin_bit_cast(float, c.x << 16); b0[1] = __builtin_bit_cast(float, c.x & 0xffff0000u); b0[2] = __builtin_bit_cast(float, c.y << 16); b0[3] = __builtin_bit_cast(float, c.y & 0xffff0000u);
                b1[0] = __builtin_bit_cast(float, c.z << 16); b1[1] = __builtin_bit_cast(float, c.z & 0xffff0000u); b1[2] = __builtin_bit_cast(float, c.w << 16); b1[3] = __builtin_bit_cast(float, c.w & 0xffff0000u);
                const f32x4 o0 = b0 + acc[ai][bj][m][0] * alpha, o1 = b1 + acc[ai][bj][m][1] * alpha;
                if (out) { *(f32x4*)(out + off + bj * HALF) = o0; *(f32x4*)(out + off + bj * HALF + 4) = o1; }
                else { u32x4 w; w.x = cvt_pk_bf16(o0[0], o0[1]); w.y = cvt_pk_bf16(o0[2], o0[3]); w.z = cvt_pk_bf16(o1[0], o1[1]); w.w = cvt_pk_bf16(o1[2], o1[3]);
                    *(u32x4*)(hb + off + bj * HALF) = w;
                    const float r0 = __builtin_bit_cast(float, w.x << 16), r1 = __builtin_bit_cast(float, w.x & 0xffff0000u), r2 = __builtin_bit_cast(float, w.y << 16), r3 = __builtin_bit_cast(float, w.y & 0xffff0000u);
                    const float r4 = __builtin_bit_cast(float, w.z << 16), r5 = __builtin_bit_cast(float, w.z & 0xffff0000u), r6 = __builtin_bit_cast(float, w.w << 16), r7 = __builtin_bit_cast(float, w.w & 0xffff0000u);
                    s += ((r0 * r0 + r1 * r1) + (r2 * r2 + r3 * r3)) + ((r4 * r4 + r5 * r5) + (r6 * r6 + r7 * r7)); } }
            if (!out) { s += __shfl_xor(s, 16); s += __shfl_xor(s, 32); if (fq == 0) xs[(ai * HALF + wr * 64 + m * 16 + fr) * 4 + wc] = s; }
            asm volatile("" ::: "memory");
#pragma unroll
            for (int bj = 0; bj < 2; ++bj) cur[bj] = nxt[bj];
        }
        if (!out) {
            asm volatile("s_waitcnt lgkmcnt(0)\n\ts_barrier" ::: "memory");
            int t = threadIdx.x; asm volatile("" : "+v"(t));
            if (t < 256) { const f32x4 v = *(const PG8_LAS f32x4*)(xs + t * 4); ssq[(size_t)(u.pm * BM + t) * 4 + u.pn] = (v[0] + v[1]) + (v[2] + v[3]); }
        }
    }
};

struct EpiHead {
    static constexpr bool PERM = true, AFTER_DRAIN = false; static constexpr int NSTORES = 0;
    bf16_t* O; int ldc; const PG8_LAS float* tab;
    int lo1, hi1, lo2, hi2, lo3, hi3, logf_tile;
    const PG8_LAS float* gtab;
    float* logf;
    __device__ __forceinline__ void operator()(const f32x4 (&acc)[2][2][4][2], const Unit& u, int wr, int wc, int fr, int fq, int ui) const {
        const int row0 = u.pm * BM + wr * 64 + fr; const int pn = u.pn;
        if (pn == logf_tile) {
            if (wc == 0 && fq < 2) {
                float rsv[2][4]; rows_rstd_lds(tab, ui, wr * 64 + fr, rsv);
#pragma unroll
                for (int ai = 0; ai < 2; ++ai)
#pragma unroll
                    for (int m = 0; m < 4; ++m) { const int row = row0 + ai * HALF + m * 16; const float rs = rsv[ai][m]; const int b = row >> 12, t = row & 4095;
#pragma unroll
                        for (int n = 0; n < 2; ++n)
#pragma unroll
                            for (int j = 0; j < 4; ++j) { const int e = 8 * fq + 4 * n + j;
                                if (e < 12) { const float x = acc[ai][0][m][n][j] * rs + gtab[192 + e]; const float ls = fminf(x, 0.f) - log1pf(__expf(-fabsf(x))); logf[(size_t)(b * 12 + e) * 4096 + t] = ls; } } }
            }
            return;
        }
        const PG8_LAS float* gn = nullptr;
        if (pn >= lo1 && pn < hi1) gn = gtab; else if (pn >= lo2 && pn < hi2) gn = gtab + 64; else if (pn >= lo3 && pn < hi3) gn = gtab + 128;
        f32x4 gv[2][2];
#pragma unroll
        for (int bj = 0; bj < 2; ++bj)
#pragma unroll
            for (int n = 0; n < 2; ++n) { if (gn) { gv[bj][n] = *(const PG8_LAS f32x4*)(gn + 32 * bj + 8 * fq + 4 * n); } else gv[bj][n] = (f32x4){1.f, 1.f, 1.f, 1.f}; }
        const int col0 = pn * BM + wc * 64 + 8 * fq;
        float rsv[2][4]; rows_rstd_lds(tab, ui, wr * 64 + fr, rsv);
#pragma unroll
        for (int ai = 0; ai < 2; ++ai)
#pragma unroll
            for (int m = 0; m < 4; ++m) { const int row = row0 + ai * HALF + m * 16; const float rs = rsv[ai][m];
                f32x4 v[2][2]; float s = 0.f;
#pragma unroll
                for (int bj = 0; bj < 2; ++bj)
#pragma unroll
                    for (int n = 0; n < 2; ++n) { v[bj][n] = acc[ai][bj][m][n] * rs; s += (v[bj][n][0] * v[bj][n][0] + v[bj][n][1] * v[bj][n][1]) + (v[bj][n][2] * v[bj][n][2] + v[bj][n][3] * v[bj][n][3]); }
                float hs = 1.f;
                if (gn) { s += __shfl_xor(s, 16); s += __shfl_xor(s, 32); hs = __builtin_amdgcn_rsqf(s * (1.0f / 64.0f) + NORM_EPS_F); }
#pragma unroll
                for (int bj = 0; bj < 2; ++bj) { const f32x4 a = v[bj][0] * gv[bj][0] * hs, c = v[bj][1] * gv[bj][1] * hs;
                    u32x4 w; w.x = cvt_pk_bf16(a[0], a[1]); w.y = cvt_pk_bf16(a[2], a[3]); w.z = cvt_pk_bf16(c[0], c[1]); w.w = cvt_pk_bf16(c[2], c[3]);
                    *(u32x4*)(O + (size_t)row * ldc + col0 + 32 * bj) = w; }
                asm volatile("" ::: "memory"); }
    }
};

template <class Epi, class Sched, bool ALIGN_EPI = false, bool SP2 = false>
__device__ __forceinline__ void gemm_phase(PG8_LAS unsigned char* lds, const Gemm g, const Sched& S, const Epi& E) {
    int tid_ = threadIdx.x; asm volatile("" : "+v"(tid_)); const int tid = tid_, wid = __builtin_amdgcn_readfirstlane(tid >> 6), lane = tid & 63, wr = wid >> 2, wc = wid & 3, fr = lane & 15, fq = lane >> 4;
    const int K = g.K, nt = K / BK;
    unsigned voffA[2], voffB[2];
#pragma unroll
    for (int i = 0; i < 2; ++i) { int R, C; stage_rc(tid * 16 + i * 8192, R, C); const int Rb = Epi::PERM ? ((R & ~31) + perm32(R & 31)) : R;
        voffA[i] = (unsigned)(R * K + C) * 2u; voffB[i] = (unsigned)(Rb * K + C) * 2u; }
    const size_t kstep = (size_t)(BK * 2);
    const size_t hstep = (size_t)HALF * K * 2;
    const size_t tstep = 2 * hstep;
    const unsigned ldsw = (unsigned)wid * 1024u;
    const int aoff = lds_byte(wr * 64 + fr, fq * 8), boff = lds_byte(wc * 32 + fr, fq * 8);
#define PG8_SA(b, h) (((b) * 2 + (h)) * HTB)
#define PG8_SB(b, h) ((4 + (b) * 2 + (h)) * HTB)
#define PG8_STAGE(bufoff, gbase, voff) do { _Pragma("unroll") for (int _i = 0; _i < 2; ++_i) \
        __builtin_amdgcn_global_load_lds((const unsigned*)((const char*)(gbase) + (voff)[_i]), (PG8_LAS unsigned*)(lds + (bufoff) + ldsw + _i * 8192), 16, 0, 0); } while (0)
#define PG8_LDA(dst, b, h) do { _Pragma("unroll") for (int m = 0; m < 4; ++m) _Pragma("unroll") for (int k = 0; k < 2; ++k) dst[m][k] = *(const PG8_LAS bf16x8*)(lds + PG8_SA(b, h) + aoff + m * 2048 + k * 1024); } while (0)
#define PG8_LDB(dst, b, h) do { _Pragma("unroll") for (int n = 0; n < 2; ++n) _Pragma("unroll") for (int k = 0; k < 2; ++k) dst[n][k] = *(const PG8_LAS bf16x8*)(lds + PG8_SB(b, h) + boff + n * 2048 + k * 1024); } while (0)
#define PG8_MMA(ai, bj, At, Bt) do { __builtin_amdgcn_s_setprio(1); _Pragma("unroll") for (int m = 0; m < 4; ++m) _Pragma("unroll") for (int n = 0; n < 2; ++n) _Pragma("unroll") for (int k = 0; k < 2; ++k) \
        acc[ai][bj][m][n] = __builtin_amdgcn_mfma_f32_16x16x32_bf16(Bt[n][k], At[m][k], acc[ai][bj][m][n], 0, 0, 0); __builtin_amdgcn_s_setprio(0); } while (0)
#define PG8_WAIT_V(n) asm volatile("s_waitcnt vmcnt(" #n ")" ::: "memory")
#define PG8_WAIT_L(n) asm volatile("s_waitcnt lgkmcnt(" #n ")" ::: "memory")
#define PG8_WAIT_VN(n) asm volatile("s_waitcnt vmcnt(" #n ")" ::: "memory")
#define PG8_TRIP_SP2(W) do { PG8_LDB(B0, 0, 0); PG8_LDB(B1, 0, 1); PG8_SCHED; PG8_LDA(At, 0, 0); PG8_STAGE(PG8_SA(1, 1), a1 + hstep, voffA); PG8_WAIT_VN(W); PG8_WAIT_L(0); PG8_BAR; PG8_MMA(0, 0, At, B0); PG8_MMA(0, 1, At, B1); PG8_BAR; PG8_SCHED; PG8_LDA(At, 0, 1); PG8_STAGE(PG8_SB(0, 0), b2, voffB); PG8_STAGE(PG8_SB(0, 1), b2 + hstep, voffB); PG8_STAGE(PG8_SA(0, 0), a2, voffA); PG8_WAIT_VN(W); PG8_WAIT_L(0); PG8_BAR; PG8_MMA(1, 0, At, B0); PG8_MMA(1, 1, At, B1); PG8_BAR; PG8_SCHED; PG8_LDB(B0, 1, 0); PG8_LDB(B1, 1, 1); PG8_SCHED; PG8_LDA(At, 1, 0); PG8_STAGE(PG8_SA(0, 1), a2 + hstep, voffA); PG8_WAIT_V(8); PG8_WAIT_L(0); PG8_BAR; PG8_MMA(0, 0, At, B0); PG8_MMA(0, 1, At, B1); PG8_BAR; PG8_SCHED; PG8_LDA(At, 1, 1); PG8_STAGE(PG8_SB(1, 0), b3, voffB); PG8_STAGE(PG8_SB(1, 1), b3 + hstep, voffB); PG8_STAGE(PG8_SA(1, 0), a3, voffA); PG8_WAIT_V(8); PG8_WAIT_L(0); PG8_BAR; PG8_MMA(1, 0, At, B0); PG8_MMA(1, 1, At, B1); PG8_BAR; PG8_SCHED; } while (0)
#define PG8_WAIT_V8_OR_16_UNUSED(f) asm volatile("s_cmp_lg_u32 %0, 0\n\ts_cbranch_scc1 .Lpg8w%=\n\ts_waitcnt vmcnt(8)\n.Lpg8w%=:\n\ts_waitcnt vmcnt(16)" :: "s"(f) : "memory", "scc")
#define PG8_BAR __builtin_amdgcn_s_barrier()
#define PG8_SCHED __builtin_amdgcn_sched_barrier(0)
    Unit cur, nxt; int ui = 0;
    if (!S.next(0, cur)) return;
    f32x4 acc[2][2][4][2];
#pragma unroll
    for (int a = 0; a < 2; ++a)
#pragma unroll
        for (int b = 0; b < 2; ++b)
#pragma unroll
            for (int m = 0; m < 4; ++m)
#pragma unroll
                for (int n = 0; n < 2; ++n) acc[a][b][m][n] = (f32x4){0.f, 0.f, 0.f, 0.f};
    bf16x8 At[4][2], B0[2][2], B1[2][2];
    const char* cA = (const char*)g.A + (size_t)(cur.pm & g.pmask) * tstep; const char* cB = (const char*)g.Bt + (size_t)(cur.pn & g.nmask) * tstep;
    S.a_ready(cur, 0);
    if constexpr (SP2) {
        PG8_STAGE(PG8_SB(0, 0), cB, voffB); PG8_STAGE(PG8_SB(0, 1), cB + hstep, voffB); PG8_STAGE(PG8_SA(0, 0), cA, voffA); PG8_STAGE(PG8_SA(0, 1), cA + hstep, voffA);
        if (wr == 1) PG8_BAR;
        PG8_WAIT_V(2); PG8_BAR;
        PG8_STAGE(PG8_SB(1, 0), cB + kstep, voffB); PG8_STAGE(PG8_SA(1, 0), cA + kstep, voffA); PG8_STAGE(PG8_SB(1, 1), cB + hstep + kstep, voffB);
        PG8_WAIT_V(6); PG8_BAR;
        S.a_commit(0);
    } else {
        PG8_STAGE(PG8_SB(0, 0), cB, voffB); PG8_STAGE(PG8_SA(0, 0), cA, voffA); PG8_STAGE(PG8_SB(0, 1), cB + hstep, voffB); PG8_STAGE(PG8_SA(0, 1), cA + hstep, voffA);
        if (wr == 1) PG8_BAR;
        PG8_WAIT_V(4); PG8_BAR;
        PG8_STAGE(PG8_SB(1, 0), cB + kstep, voffB); PG8_STAGE(PG8_SA(1, 0), cA + kstep, voffA); PG8_STAGE(PG8_SB(1, 1), cB + hstep + kstep, voffB);
        PG8_WAIT_V(6); PG8_BAR;
        S.a_commit(0);
    }
    for (;;) {
        const bool has_next = S.next(ui + 1, nxt);
        const char* nA = has_next ? (const char*)g.A + (size_t)(nxt.pm & g.pmask) * tstep : cA; const char* nB = has_next ? (const char*)g.Bt + (size_t)(nxt.pn & g.nmask) * tstep : cB;
        for (int t = 0; t < nt; t += 2) {
            const bool last = (t == nt - 2);
            const char* a1 = cA + (size_t)(t + 1) * kstep;
            const char* a2 = last ? nA : cA + (size_t)(t + 2) * kstep; const char* b2 = last ? nB : cB + (size_t)(t + 2) * kstep;
            const char* a3 = a2 + kstep; const char* b3 = b2 + kstep;
            if (last && has_next) S.a_ready(nxt, ui + 1);
            if constexpr (SP2) {
            PG8_TRIP_SP2(8);
            if (last && has_next) S.a_commit(ui + 1);
            } else {
            PG8_LDB(B0, 0, 0); PG8_SCHED; PG8_LDA(At, 0, 0); PG8_STAGE(PG8_SA(1, 1), a1 + hstep, voffA);
            PG8_WAIT_L(8); PG8_BAR; PG8_WAIT_L(0); PG8_MMA(0, 0, At, B0); PG8_BAR; PG8_SCHED;
            PG8_LDB(B1, 0, 1); PG8_STAGE(PG8_SB(0, 0), b2, voffB);
            PG8_BAR; PG8_WAIT_L(0); PG8_MMA(0, 1, At, B1); PG8_BAR;
            PG8_LDA(At, 0, 1); PG8_STAGE(PG8_SA(0, 0), a2, voffA);
            PG8_BAR; PG8_WAIT_L(0); PG8_MMA(1, 0, At, B0); PG8_BAR; PG8_SCHED;
            PG8_STAGE(PG8_SB(0, 1), b2 + hstep, voffB);
            PG8_WAIT_V(6); PG8_BAR; PG8_MMA(1, 1, At, B1); PG8_BAR;
            PG8_LDB(B0, 1, 0); PG8_SCHED; PG8_LDA(At, 1, 0); PG8_STAGE(PG8_SA(0, 1), a2 + hstep, voffA);
            PG8_WAIT_L(8); PG8_BAR; PG8_WAIT_L(0); PG8_MMA(0, 0, At, B0); PG8_BAR; PG8_SCHED;
            PG8_LDB(B1, 1, 1); PG8_STAGE(PG8_SB(1, 0), b3, voffB);
            PG8_BAR; PG8_WAIT_L(0); PG8_MMA(0, 1, At, B1); PG8_BAR;
            PG8_LDA(At, 1, 1); PG8_STAGE(PG8_SA(1, 0), a3, voffA);
            PG8_BAR; PG8_WAIT_L(0); PG8_MMA(1, 0, At, B0); PG8_BAR; PG8_SCHED;
            PG8_STAGE(PG8_SB(1, 1), b3 + hstep, voffB);
            PG8_WAIT_V(6); PG8_BAR; PG8_MMA(1, 1, At, B1); PG8_BAR;
            if (last && has_next) S.a_commit(ui + 1);
            }
        }
        if constexpr (ALIGN_EPI) { if (wr == 0) PG8_BAR; }
        if constexpr (!Epi::AFTER_DRAIN) { E(acc, cur, wr, wc, fr, fq, ui); S.done(cur); }
        if (!has_next) break;
#pragma unroll
        for (int a = 0; a < 2; ++a)
#pragma unroll
            for (int b = 0; b < 2; ++b)
#pragma unroll
                for (int m = 0; m < 4; ++m)
#pragma unroll
                    for (int n = 0; n < 2; ++n) acc[a][b][m][n] = (f32x4){0.f, 0.f, 0.f, 0.f};
        cur = nxt; cA = nA; cB = nB; ++ui;
        if constexpr (ALIGN_EPI) { if (wr == 1) PG8_BAR; }
    }
    PG8_WAIT_V(0);
    if constexpr (!ALIGN_EPI) { if (wr == 0) PG8_BAR; }
    PG8_BAR;
    if constexpr (Epi::AFTER_DRAIN) { E.fused(acc, cur, wr, wc, fr, fq, lds, wid, lane); S.done(cur); }
#undef PG8_SA
#undef PG8_SB
#undef PG8_STAGE
#undef PG8_LDA
#undef PG8_LDB
#undef PG8_MMA
#undef PG8_WAIT_V
#undef PG8_WAIT_L
#undef PG8_WAIT_VN
#undef PG8_TRIP_SP2
#undef PG8_BAR
#undef PG8_SCHED
}
}
#define PG8_SP2 true
#include <hip/hip_bf16.h>
#include <cmath>
namespace attn_body {
using bf16=__hip_bfloat16;
using bf16x8=__attribute__((ext_vector_type(8)))short;
using s16x4=__attribute__((ext_vector_type(4)))short;
using f32x16=__attribute__((ext_vector_type(16)))float;
using u32x4=__attribute__((ext_vector_type(4)))unsigned;
using f32x4v=__attribute__((ext_vector_type(4)))float;
constexpr int SEQ=4096,D=64;
constexpr int NW=8,QBLK=32,QB=QBLK*NW,KVBLK=64,NQB=SEQ/QB;
constexpr int ATTN_UNIT_ROWS=QB;
__device__ __forceinline__ int crow(int r,int hi){return (r&3)+8*(r>>2)+4*hi;}
#define SBAR() __builtin_amdgcn_sched_barrier(0)
__device__ __forceinline__ void cmask(f32x16&p0,f32x16&p1,int jb,int qrel,int hi){
  const float NEG=-INFINITY; int x=qrel-64*jb-4*hi; asm volatile("":"+v"(x));
  #pragma unroll
  for(int r=0;r<16;++r){const int c=(r&3)+8*(r>>2); if(c>x)p0[r]=NEG; if(c+32>x)p1[r]=NEG;}
}

constexpr int NSLOT=3, SLOTB=8192;
constexpr int LDS_K=0, LDS_V=NSLOT*SLOTB, LDS_WS=2*NSLOT*SLOTB, LDS_OST=LDS_WS+NW*64*4, LDS_CK=LDS_OST+NW*4096, LDS_BYTES=LDS_CK+SEQ*4;
constexpr float C2=0.125f*1.4426950408889634f;
__device__ __forceinline__ void glds16(const void*gsrc,unsigned lds_dst){unsigned keep;
  asm volatile("s_mov_b32 %0, m0\n\ts_mov_b32 m0, %2\n\ts_nop 0\n\tglobal_load_lds_dwordx4 %1, off\n\ts_mov_b32 m0, %0":"=&s"(keep):"v"(gsrc),"s"(lds_dst):"memory");}
__device__ __forceinline__ float max3f(float a,float b,float c){float r;asm("v_max3_f32 %0, %1, %2, %3":"=v"(r):"v"(a),"v"(b),"v"(c));return r;}
__device__ __forceinline__ float max2f(float a,float b){float r;asm("v_max_f32_e32 %0, %1, %2":"=v"(r):"v"(a),"v"(b));return r;}
__device__ __forceinline__ float fadd_s(float a,float b){float r;asm("v_add_f32_e32 %0, %1, %2":"=v"(r):"v"(a),"v"(b));return r;}
__device__ __forceinline__ float fsub_s(float a,float b){float r;asm("v_sub_f32_e32 %0, %1, %2":"=v"(r):"v"(a),"v"(b));return r;}
typedef float f32x2_t __attribute__((ext_vector_type(2))); typedef __bf16 bf16x2_t __attribute__((ext_vector_type(2)));
__device__ __forceinline__ unsigned cvtpk_s(float lo,float hi){f32x2_t v={lo,hi};bf16x2_t b=__builtin_convertvector(v,bf16x2_t);return __builtin_bit_cast(unsigned,b);}
#define WAIT_BAR(N) asm volatile("s_waitcnt vmcnt(" #N ") lgkmcnt(0)\n\ts_barrier":::"memory")

__device__ __forceinline__ void qkt(f32x16&p0,f32x16&p1,const char*Kslot,const bf16x8*qr,int r32,int hi){
  const char*kb=Kslot+hi*1024+r32*16;
  #pragma unroll
  for(int d0=0;d0<4;++d0){
    const bf16x8 b0=*reinterpret_cast<const bf16x8*>(kb+d0*2048);
    const bf16x8 b1=*reinterpret_cast<const bf16x8*>(kb+d0*2048+512);
    {p0=__builtin_amdgcn_mfma_f32_32x32x16_bf16(b0,qr[d0],p0,0,0,0);p1=__builtin_amdgcn_mfma_f32_32x32x16_bf16(b1,qr[d0],p1,0,0,0);}}
}
typedef __attribute__((address_space(3))) const char* lds_cptr;
typedef short v4i16_t __attribute__((ext_vector_type(4)));
__device__ __forceinline__ void kload8(bf16x8*kf,lds_cptr kp){
  kf[0]=*(const __attribute__((address_space(3))) bf16x8*)(kp);      kf[1]=*(const __attribute__((address_space(3))) bf16x8*)(kp+512);
  kf[2]=*(const __attribute__((address_space(3))) bf16x8*)(kp+2048); kf[3]=*(const __attribute__((address_space(3))) bf16x8*)(kp+2560);
  kf[4]=*(const __attribute__((address_space(3))) bf16x8*)(kp+4096); kf[5]=*(const __attribute__((address_space(3))) bf16x8*)(kp+4608);
  kf[6]=*(const __attribute__((address_space(3))) bf16x8*)(kp+6144); kf[7]=*(const __attribute__((address_space(3))) bf16x8*)(kp+6656);
}
__device__ __forceinline__ void kload2(bf16x8*kf,lds_cptr kp,int j){ kf[2*j]=*(const __attribute__((address_space(3))) bf16x8*)(kp+j*2048); kf[2*j+1]=*(const __attribute__((address_space(3))) bf16x8*)(kp+j*2048+512); }
__device__ __forceinline__ s16x4 vtr(lds_cptr p){ return __builtin_bit_cast(s16x4,__builtin_amdgcn_ds_read_tr16_b64_v4i16((__attribute__((address_space(3))) v4i16_t*)p)); }
__device__ __forceinline__ float rowmax(const f32x16&p0,const f32x16&p1){
  float a=max3f(p0[0],p0[1],p1[0]),b=max3f(p0[2],p0[3],p1[1]);a=max3f(a,p1[2],p1[3]);
  #pragma unroll
  for(int r=4;r<16;r+=4){a=max3f(a,p0[r],p0[r+1]);b=max3f(b,p0[r+2],p0[r+3]);a=max3f(a,p1[r],p1[r+1]);b=max3f(b,p1[r+2],p1[r+3]);}
  const float m=max2f(a,b);
  auto rr=__builtin_amdgcn_permlane32_swap(__float_as_uint(m),__float_as_uint(m),false,false);
  return max2f(__uint_as_float(rr[0]),__uint_as_float(rr[1]));
}
__device__ __forceinline__ void pv(f32x16*o,int vb,bf16x8 pa0,bf16x8 pa1,bf16x8 pa2,bf16x8 pa3){
  #pragma unroll
  for(int d0=0;d0<2;++d0){s16x4 lo[4],hi[4];
    #pragma unroll
    for(int ks=0;ks<4;++ks){
      asm volatile("ds_read_b64_tr_b16 %0,%1 offset:%c2":"=&v"(lo[ks]):"v"(vb),"i"(d0*4096+ks*1024):"memory");
      asm volatile("ds_read_b64_tr_b16 %0,%1 offset:%c2":"=&v"(hi[ks]):"v"(vb),"i"(d0*4096+ks*1024+512):"memory");}
    asm volatile("s_waitcnt lgkmcnt(0)":::"memory");SBAR();
    #define PK(k) (bf16x8){lo[k][0],lo[k][1],lo[k][2],lo[k][3],hi[k][0],hi[k][1],hi[k][2],hi[k][3]}
    o[d0]=__builtin_amdgcn_mfma_f32_32x32x16_bf16(pa0,PK(0),o[d0],0,0,0);
    o[d0]=__builtin_amdgcn_mfma_f32_32x32x16_bf16(pa1,PK(1),o[d0],0,0,0);
    o[d0]=__builtin_amdgcn_mfma_f32_32x32x16_bf16(pa2,PK(2),o[d0],0,0,0);
    o[d0]=__builtin_amdgcn_mfma_f32_32x32x16_bf16(pa3,PK(3),o[d0],0,0,0);
    #undef PK
  }
}

#ifndef ATTN_STORE16
#define ATTN_STORE16(p,v) (*(u32x4*)(p)=(v))
#endif
template<bool CAUSAL,int THRL,bool NOBIAS=false> __device__ __forceinline__ void attn_unit(const bf16*Qw0,int qpitch,const bf16*__restrict__ Kh,const bf16*__restrict__ Vh,int kvpitch,bf16*Ow0,int opitch,int NT,const float*ckg,char*shm){
  const int tid=threadIdx.x; int lane_=tid&63; asm volatile("":"+v"(lane_)); const int lane=lane_,r32=lane&31,hi=lane>>5; const int wid=__builtin_amdgcn_readfirstlane(tid>>6);
  const bf16*Qw=Qw0+(long)(wid*QBLK)*qpitch;
  const unsigned lds0=(unsigned)(uintptr_t)shm;
  float*wsf=(float*)(shm+LDS_WS)+wid*64;
  const bf16*ksrc=Kh+(long)lane*kvpitch+wid*8;
  const bf16*vsrc=Vh+(long)(16*(wid&3)+(lane>>2))*kvpitch+(wid>>2)*32+(lane&3)*8;
  const unsigned kdst=lds0+LDS_K+wid*1024, vdst=lds0+LDS_V+wid*1024;
  #define DMA_K(t,slot) glds16(ksrc+(long)(t)*KVBLK*kvpitch,(unsigned)__builtin_amdgcn_readfirstlane(kdst+(slot)))
  #define DMA_V(t,slot) glds16(vsrc+(long)(t)*KVBLK*kvpitch,(unsigned)__builtin_amdgcn_readfirstlane(vdst+(slot)))
  const int vb0=(int)(lds0+LDS_V)+((lane>>4)&1)*32+(lane&3)*8+(4*hi+((lane&15)>>2))*64;
  const char*Kbase=shm+LDS_K; bf16x8 kf[8];
  const lds_cptr shm3=(lds_cptr)shm; const lds_cptr kp0=shm3+LDS_K+hi*1024+r32*16; const lds_cptr vp0=shm3+LDS_V+((lane>>4)&1)*32+(lane&3)*8+(4*hi+((lane&15)>>2))*64;
  DMA_K(0,0);DMA_V(0,0);DMA_K(1,SLOTB);
  bf16x8 qr[4];
  #pragma unroll
  for(int d0=0;d0<4;++d0)qr[d0]=*reinterpret_cast<const bf16x8*>(&Qw[(long)r32*qpitch+d0*16+hi*8]);
  typedef __attribute__((address_space(3))) float lds_f32; typedef __attribute__((address_space(3))) f32x4v lds_f32x4;
  lds_f32* const ckl=(lds_f32*)((lds_cptr)shm+LDS_CK);
  constexpr bool BIAS=CAUSAL&&!NOBIAS;
  if(BIAS){ _Pragma("unroll") for(int i_=0;i_<2;++i_){ const int e4=(tid+512*i_)*4; if(e4<NT*KVBLK){ const f32x4v cv=*(const f32x4v*)(ckg+e4); *(lds_f32x4*)(ckl+e4)=cv; } } }
  float mhat=0.f,l_reg=0.f;f32x16 o[2];o[0]=f32x16{};o[1]=f32x16{};
  #define CINITH(C0,t,OFS) do{ const float nm_=-mhat; if(BIAS){ const lds_f32* cp_=ckl+(t)*KVBLK+4*hi+(OFS); \
      _Pragma("unroll") for(int g_=0;g_<4;++g_){ const f32x4v a_=*(const lds_f32x4*)(cp_+8*g_); \
        _Pragma("unroll") for(int j_=0;j_<4;++j_){ C0[4*g_+j_]=nm_-a_[j_]; } } } \
    else { _Pragma("unroll") for(int r_=0;r_<16;++r_){ C0[r_]=nm_; } } }while(0)
  #define CINIT(C0,C1,t) do{ CINITH(C0,t,0); CINITH(C1,t,32); }while(0)
  #define CLOAD(C0,t,OFS) do{ if(BIAS){ const lds_f32* cp_=ckl+(t)*KVBLK+4*hi+(OFS); \
      _Pragma("unroll") for(int g_=0;g_<4;++g_){ const f32x4v a_=*(const lds_f32x4*)(cp_+8*g_); C0[4*g_]=a_[0]; C0[4*g_+1]=a_[1]; C0[4*g_+2]=a_[2]; C0[4*g_+3]=a_[3]; } } }while(0)
  #define CSUB(C0) do{ const float nm_=-mhat; if(BIAS){ _Pragma("unroll") for(int r_=0;r_<16;++r_) C0[r_]=nm_-C0[r_]; } else { _Pragma("unroll") for(int r_=0;r_<16;++r_) C0[r_]=nm_; } }while(0)
  const int qrel=wid*QBLK+r32;
  #define CMASK(P0,P1,t) do{ if(CAUSAL){int jb_=(t)-(NT-4); if(jb_>=0)cmask(P0,P1,jb_,qrel,hi);} }while(0)
  bool resc=false;
  #define START(P0,P1) do{ const float rm=rowmax(P0,P1); resc=false; \
    { const float dl=rm; mhat=fadd_s(mhat,dl); \
      _Pragma("unroll") for(int r=0;r<16;++r){P0[r]=fsub_s(P0[r],dl);P1[r]=fsub_s(P1[r],dl);} } \
    _Pragma("unroll") for(int r=0;r<16;++r)P0[r]=__builtin_amdgcn_exp2f(P0[r]); }while(0)
  #define RESC() do{ if(resc){ asm volatile("s_waitcnt lgkmcnt(0)":::"memory"); \
      _Pragma("unroll") for(int d_=0;d_<2;++d_) _Pragma("unroll") for(int r=0;r<16;++r)o[d_][r]*=wsf[crow(r,hi)]; } }while(0)
  f32x16 pA0,pA1,pB0,pB1;
  int sl_prev=0,sl_cur=0,sl_next=SLOTB;
  #define ROT() do{sl_prev=sl_cur;sl_cur=sl_next;sl_next=(sl_next==(NSLOT-1)*SLOTB)?0:sl_next+SLOTB;}while(0)
  DMA_K(2,2*SLOTB);
  WAIT_BAR(3);
  CINIT(pA0,pA1,0); qkt(pA0,pA1,Kbase,qr,r32,hi);asm volatile("s_nop 15\n\ts_nop 7":"+v"(pA0),"+v"(pA1));CMASK(pA0,pA1,0);
  START(pA0,pA1);
  _Pragma("unroll") for(int r=0;r<16;++r)pA1[r]=__builtin_amdgcn_exp2f(pA1[r]);
  CINIT(pB0,pB1,1);
  WAIT_BAR(0);
  DMA_K(3,0);DMA_V(1,SLOTB);
  ROT();
  kload8(kf,kp0+sl_cur);
  WAIT_BAR(2);
  s16x4 vlo[8],vhi[8]; u32x4 pw0,pw1,pw2,pw3;
  #define PKW(P,B) cvtpk_s(P[B],P[B+1])
  #define PAF(k) __builtin_bit_cast(bf16x8,pw##k)
  #define VFR(i) (bf16x8){vlo[i][0],vlo[i][1],vlo[i][2],vlo[i][3],vhi[i][0],vhi[i][1],vhi[i][2],vhi[i][3]}
  #define PIN(x) asm volatile("":"+v"(x))
  #define MX3(a,b,c) __builtin_fmaxf(__builtin_fmaxf((a),(b)),(c))
  #define GAPA(MF,A0,A1,A2,A3,W0,W1,PW) do{ MF; sacc+=A0; sacc+=A1; sacc+=A2; sacc+=A3; PIN(sacc); W0; W1; PIN(PW); SBAR(); }while(0)
  #define EX(v) __builtin_amdgcn_exp2f(v)
  #define GAPB(MF,X,B) do{ MF; X[B]=EX(X[B]); X[B+1]=EX(X[B+1]); X[B+2]=EX(X[B+2]); X[B+3]=EX(X[B+3]); PIN(X); SBAR(); }while(0)
  #define VRD(i) do{ vlo[i]=vtr(vp_+(((i)>>2)*4096+((i)&3)*1024)); vhi[i]=vtr(vp_+(((i)>>2)*4096+((i)&3)*1024+512)); }while(0)
  #define KRD(G,j) do{ if(G){ kload2(kf,kp0+sl_next,j); SBAR(); } }while(0)
  #define STEP(C0,C1,P0,P1,t,GK,GV,GL) do{ SBAR(); \
    const lds_cptr vp_=vp0+sl_prev; \
    VRD(0); SBAR(); float sacc=(P0[0]+P0[1]); \
    GAPA(C0=__builtin_amdgcn_mfma_f32_32x32x16_bf16(kf[0],qr[0],C0,0,0,0), P0[2],P0[3],P0[4],P0[5],     pw0[0]=PKW(P0,0), pw0[1]=PKW(P0,2), pw0); \
    VRD(4); SBAR(); GAPA(C1=__builtin_amdgcn_mfma_f32_32x32x16_bf16(kf[1],qr[0],C1,0,0,0), P0[6],P0[7],P0[8],P0[9],     pw0[2]=PKW(P0,4), pw0[3]=PKW(P0,6), pw0); \
    VRD(1); SBAR(); GAPA(C0=__builtin_amdgcn_mfma_f32_32x32x16_bf16(kf[2],qr[1],C0,0,0,0),   P0[10],P0[11],P0[12],P0[13], pw1[0]=PKW(P0,8), pw1[1]=PKW(P0,10), pw1); \
    VRD(5); SBAR(); GAPA(C1=__builtin_amdgcn_mfma_f32_32x32x16_bf16(kf[3],qr[1],C1,0,0,0),   P0[14],P0[15],P1[0],P1[1],   pw1[2]=PKW(P0,12),pw1[3]=PKW(P0,14), pw1); \
    VRD(2); SBAR(); GAPA(C0=__builtin_amdgcn_mfma_f32_32x32x16_bf16(kf[4],qr[2],C0,0,0,0),   P1[2],P1[3],P1[4],P1[5],     pw2[0]=PKW(P1,0), pw2[1]=PKW(P1,2), pw2); \
    VRD(6); SBAR(); GAPA(C1=__builtin_amdgcn_mfma_f32_32x32x16_bf16(kf[5],qr[2],C1,0,0,0),   P1[6],P1[7],P1[8],P1[9],     pw2[2]=PKW(P1,4), pw2[3]=PKW(P1,6), pw2); \
    VRD(3); SBAR(); GAPA(C0=__builtin_amdgcn_mfma_f32_32x32x16_bf16(kf[6],qr[3],C0,0,0,0),   P1[10],P1[11],P1[12],P1[13], pw3[0]=PKW(P1,8), pw3[1]=PKW(P1,10), pw3); \
    VRD(7); SBAR(); GAPA(C1=__builtin_amdgcn_mfma_f32_32x32x16_bf16(kf[7],qr[3],C1,0,0,0),   P1[14],P1[15],0.f,0.f,       pw3[2]=PKW(P1,12),pw3[3]=PKW(P1,14), pw3); \
    l_reg+=sacc; \
    if(GK){DMA_K((t)+3,sl_cur);} if(GV){DMA_V((t)+1,sl_next);} \
    CMASK(C0,C1,t); \
    { float a=MX3(C0[0],C0[1],C1[0]),b=MX3(C0[2],C0[3],C1[1]); a=MX3(a,C1[2],C1[3]); \
      _Pragma("unroll") for(int r=4;r<16;r+=4){a=MX3(a,C0[r],C0[r+1]);b=MX3(b,C0[r+2],C0[r+3]);a=MX3(a,C1[r],C1[r+1]);b=MX3(b,C1[r+2],C1[r+3]);} \
      float rm=__builtin_fmaxf(a,b); { auto rr=__builtin_amdgcn_permlane32_swap(__float_as_uint(rm),__float_as_uint(rm),false,false); rm=__builtin_fmaxf(__uint_as_float(rr[0]),__uint_as_float(rr[1])); } \
      resc=false; \
      if(__builtin_expect(__any(rm>(float)THRL),0)){ const float dl=__builtin_fmaxf(rm,0.f); mhat+=dl; \
        _Pragma("unroll") for(int r=0;r<16;++r){C0[r]-=dl;C1[r]-=dl;} \
        const float f=__builtin_amdgcn_exp2f(-dl); l_reg*=f; if(hi==0)wsf[r32]=f; resc=true; } } \
    SBAR(); \
    GAPB(o[0]=__builtin_amdgcn_mfma_f32_32x32x16_bf16(PAF(0),VFR(0),o[0],0,0,0), C0,0); \
    GAPB(o[1]=__builtin_amdgcn_mfma_f32_32x32x16_bf16(PAF(0),VFR(4),o[1],0,0,0), C0,4); \
    if(GV){ CINITH(P0,(t)+1,0); SBAR(); } \
    KRD(GL,0); GAPB(o[0]=__builtin_amdgcn_mfma_f32_32x32x16_bf16(PAF(1),VFR(1),o[0],0,0,0), C0,8); \
    KRD(GL,1); GAPB(o[1]=__builtin_amdgcn_mfma_f32_32x32x16_bf16(PAF(1),VFR(5),o[1],0,0,0), C0,12); \
    KRD(GL,2); GAPB(o[0]=__builtin_amdgcn_mfma_f32_32x32x16_bf16(PAF(2),VFR(2),o[0],0,0,0), C1,0); \
    KRD(GL,3); GAPB(o[1]=__builtin_amdgcn_mfma_f32_32x32x16_bf16(PAF(2),VFR(6),o[1],0,0,0), C1,4); \
    if(GV){ CINITH(P1,(t)+1,32); SBAR(); } \
    GAPB(o[0]=__builtin_amdgcn_mfma_f32_32x32x16_bf16(PAF(3),VFR(3),o[0],0,0,0), C1,8); \
    GAPB(o[1]=__builtin_amdgcn_mfma_f32_32x32x16_bf16(PAF(3),VFR(7),o[1],0,0,0), C1,12); \
    }while(0)
  int t=1;
  #undef CMASK
  #define CMASK(P0,P1,t) do{}while(0)
  for(;t+5<NT;t+=2){
    STEP(pB0,pB1,pA0,pA1,t,true,true,true);     WAIT_BAR(2); RESC(); ROT();
    STEP(pA0,pA1,pB0,pB1,t+1,true,true,true);   WAIT_BAR(2); RESC(); ROT();
  }
  #undef CMASK
  #define CMASK(P0,P1,t) do{ if(CAUSAL){int jb_=(t)-(NT-4); if(jb_>=0)cmask(P0,P1,jb_,qrel,hi);} }while(0)
  #define ENDW(tt) do{ if((tt)+3<NT){WAIT_BAR(2);} else if((tt)+2<NT){WAIT_BAR(1);} else {WAIT_BAR(0);} }while(0)
  for(;t+1<NT;t+=2){
    STEP(pB0,pB1,pA0,pA1,t,(t+3<NT),(t+1<NT),(t+1<NT));       ENDW(t);   RESC(); ROT();
    STEP(pA0,pA1,pB0,pB1,t+1,(t+4<NT),(t+2<NT),(t+2<NT));     ENDW(t+1); RESC(); ROT();
  }
  STEP(pB0,pB1,pA0,pA1,NT-1,false,false,false); RESC();
  { float sacc=pB0[0]+pB0[1]; _Pragma("unroll") for(int r=2;r<16;++r)sacc+=pB0[r]; _Pragma("unroll") for(int r=0;r<16;++r)sacc+=pB1[r]; l_reg+=sacc;
    pw0=(u32x4){PKW(pB0,0),PKW(pB0,2),PKW(pB0,4),PKW(pB0,6)};pw1=(u32x4){PKW(pB0,8),PKW(pB0,10),PKW(pB0,12),PKW(pB0,14)};pw2=(u32x4){PKW(pB1,0),PKW(pB1,2),PKW(pB1,4),PKW(pB1,6)};pw3=(u32x4){PKW(pB1,8),PKW(pB1,10),PKW(pB1,12),PKW(pB1,14)};
    SBAR(); pv(o,vb0+sl_cur,PAF(0),PAF(1),PAF(2),PAF(3)); }
  #undef PKW
  #undef PAF
  #undef VFR
  #undef PIN
  #undef MX3
  #undef GAPA
  #undef GAPB
  #undef EX
  #undef VRD
  #undef KRD
  #undef STEP
  #undef ENDW
  {auto rr=__builtin_amdgcn_permlane32_swap(__float_as_uint(l_reg),__float_as_uint(l_reg),false,false);l_reg=__uint_as_float(rr[0])+__uint_as_float(rr[1]);}
  if(hi==0)wsf[32+r32]=l_reg;asm volatile("s_waitcnt lgkmcnt(0)":::"memory");
  float rli[16];
  #pragma unroll
  for(int r=0;r<16;++r)rli[r]=__builtin_amdgcn_rcpf(wsf[32+crow(r,hi)]);
  bf16*Ow=Ow0+(long)(wid*QBLK)*opitch;
  { bf16*stg=(bf16*)(shm+LDS_OST)+wid*2048;
    #pragma unroll
    for(int r=0;r<16;++r){const int orow=crow(r,hi);
      #pragma unroll
      for(int d0=0;d0<2;++d0)stg[orow*64+d0*32+r32]=__float2bfloat16(o[d0][r]*rli[r]);}
    asm volatile("s_waitcnt lgkmcnt(0)":::"memory");
    #pragma unroll
    for(int i=0;i<4;++i){const int row=i*8+(lane>>3),ch=lane&7; const u32x4 v=*(const u32x4*)(stg+row*64+ch*8); ATTN_STORE16(Ow+(long)row*opitch+ch*8,v);} }
  asm volatile("s_waitcnt lgkmcnt(0)\n\ts_barrier":::"memory");
  #undef CINIT
  #undef CLOAD
  #undef CSUB
  #undef CINITH
  #undef DMA_K
  #undef DMA_V
  #undef CMASK
  #undef START
  #undef RESC
  #undef ROT
}
constexpr int ATTN_LDS_BYTES=LDS_BYTES;
#undef SBAR
#undef WAIT_BAR
}
#include <hip/hip_cooperative_groups.h>
namespace cg = cooperative_groups;

#define GAS __attribute__((address_space(1)))
#define LAS __attribute__((address_space(3)))
typedef unsigned short bf16;
typedef unsigned v4u __attribute__((ext_vector_type(4)));
typedef unsigned v2u __attribute__((ext_vector_type(2)));
typedef float f32x4 __attribute__((ext_vector_type(4)));
typedef float f32x16 __attribute__((ext_vector_type(16)));
typedef short bf16x8 __attribute__((ext_vector_type(8)));

constexpr int NWAVES = 8;
constexpr int BATCH = 8, SEQ = 4096, DM = 1024, M = BATCH * SEQ;
constexpr int NMEM = 256, MROWS = BATCH * NMEM;
constexpr int MIXW = 768, MEMW = 256, DFF = 2816, NH = 12, HD = 64;
constexpr int N_LRU = 2 * MIXW + MEMW;
constexpr int N_FOX_SRC = 3 * MIXW + NH + MEMW;
constexpr int N_FOX_GEMM = 2560;
constexpr int N_FOX = 2816;
constexpr float C2 = 0.125f * 1.4426950408889634f;
constexpr float LOG2E = 1.4426950408889634f;

constexpr size_t MiB = 1u << 20;
constexpr size_t WS_WRG = 1 * MiB, WS_WIG = 1 * MiB + 128 * 1024;
constexpr size_t WS_WKV = 2 * MiB, WS_WOUT0 = 3 * MiB, WS_WOUT1 = 5 * MiB, WS_WLRU = 7 * MiB, WS_WFOX = 11 * MiB;
constexpr size_t WS_W1 = 17 * MiB, W1_BYTES = 11 * MiB;
constexpr size_t WS_W2 = 61 * MiB, W2_BYTES = 5 * MiB + 512 * 1024;
constexpr size_t WS_MEMB = 83 * MiB, WS_MEMKV = 87 * MiB;
constexpr size_t WS_SSQ = 89 * MiB, WS_SSQM = 91 * MiB;
constexpr size_t WS_LOGF = 92 * MiB, WS_CK = 94 * MiB, WS_SUMM = 96 * MiB, WS_FLAGS = 97 * MiB;
constexpr size_t WS_HB = 98 * MiB, WS_CAT = 162 * MiB, WS_R = 226 * MiB, WS_END = 402 * MiB;
constexpr size_t R_AL = (size_t)M * N_LRU * 2;
static_assert(R_AL + (size_t)M * MIXW * 2 <= 176 * MiB, "R region");

constexpr int RING_BYTES = 131072, LDS_BYTES = 147456, XS_OFF = RING_BYTES, RS_OFF = XS_OFF + 4096, GT_OFF = RS_OFF + 2048, MISC_OFF = RING_BYTES + 8192;
static_assert(attn_body::ATTN_LDS_BYTES <= RING_BYTES, "attention LDS");

__device__ __forceinline__ unsigned f2bf(float f) { unsigned u = __builtin_bit_cast(unsigned, f); return (u + 0x7fffu + ((u >> 16) & 1u)) >> 16; }
__device__ __forceinline__ unsigned pk2(float lo, float hi) { return f2bf(lo) | (f2bf(hi) << 16); }
__device__ __forceinline__ float bf_lo(unsigned w) { return __builtin_bit_cast(float, w << 16); }
__device__ __forceinline__ float bf_hi(unsigned w) { return __builtin_bit_cast(float, w & 0xffff0000u); }
__device__ __forceinline__ float wave_sum(float v) {
#pragma unroll
    for (int o = 1; o < 64; o <<= 1) v += __shfl_xor(v, o);
    return v;
}

typedef GAS unsigned gu32;
#define RLX_AGENT __ATOMIC_RELAXED, __HIP_MEMORY_SCOPE_AGENT
#define XB_TMO      128
#define XB_XCNT(j)  (256  + 64 * (j))
#define XB_XSUB(j)  (1280 + 64 * (j))
#define XB_XGEN(j)  (2304 + 64 * (j))
#define XB_TOP      3328
#define XB_TOPGEN   3392
#define XCD_BAR_WORDS 3456
#define XB_SPIN_CAP (1u << 18)

__device__ __forceinline__ unsigned xb_ld(unsigned* p)              { return __hip_atomic_load(p, __ATOMIC_RELAXED, __HIP_MEMORY_SCOPE_AGENT); }
__device__ __forceinline__ unsigned xb_add(unsigned* p, unsigned v) { return __hip_atomic_fetch_add(p, v, __ATOMIC_RELAXED, __HIP_MEMORY_SCOPE_AGENT); }
__device__ __forceinline__ unsigned xb_xcc_id() { return (unsigned)__builtin_amdgcn_s_getreg((3 << 11) | 20) & 0xFu; }
#define XB_SPIN(cond, bar) do { unsigned _sp = 0; while (cond) { __builtin_amdgcn_s_sleep(1); \
    if ((++_sp & 255u) == 0u) { if (xb_ld(&(bar)[XB_TMO])) break; if (_sp > XB_SPIN_CAP) { atomicAdd(&(bar)[XB_TMO], 1u); break; } } } } while (0)

struct XcdBarrier {
    unsigned* bar; unsigned x;
    volatile LAS unsigned* st;
};

__device__ __forceinline__ XcdBarrier xcd_barrier_post(unsigned* bar, volatile LAS unsigned* st) {
    XcdBarrier b; b.bar = bar; b.x = xb_xcc_id(); b.st = st;
    if (threadIdx.x == 0) (void)xb_add(&bar[XB_XCNT(b.x)], 1u);
    return b;
}
__device__ __forceinline__ void xcd_barrier_complete(unsigned* bar, unsigned x, unsigned& nloc, unsigned& nx) {
    const unsigned G = gridDim.x * gridDim.y * gridDim.z;
    unsigned sum, cnt, mine, sp = 0u;
    for (;;) {
        sum = 0u; cnt = 0u; mine = 0u;
#pragma unroll
        for (unsigned j = 0; j < 16; ++j) { const unsigned c = xb_ld(&bar[XB_XCNT(j)]); sum += c; cnt += (c > 0u) ? 1u : 0u; mine = (j == x) ? c : mine; }
        if (sum == G) break;
        __builtin_amdgcn_s_sleep(1);
        if ((++sp & 255u) == 0u) { if (xb_ld(&bar[XB_TMO])) break; if (sp > XB_SPIN_CAP) { atomicAdd(&bar[XB_TMO], 1u); break; } }
    }
    nloc = mine > 0u ? mine : 1u; nx = cnt > 0u ? cnt : 1u;
}

__device__ __forceinline__ void xcd_barrier(const XcdBarrier& b) {
    asm volatile("s_waitcnt vmcnt(0)" ::: "memory");
    __syncthreads();
    if (threadIdx.x == 0) {
        unsigned* bar = b.bar;
        __builtin_amdgcn_s_waitcnt(0);
        unsigned nloc = b.st[0], nx = b.st[1];
        if (nloc == 0u) { xcd_barrier_complete(bar, b.x, nloc, nx); b.st[0] = nloc; b.st[1] = nx; }
        const unsigned old = xb_add(&bar[XB_XSUB(b.x)], 1u);
        const unsigned gen = old / nloc;
        if (old + 1u == (gen + 1u) * nloc) {
            __builtin_amdgcn_fence(__ATOMIC_RELEASE, "agent");
            asm volatile("s_waitcnt vmcnt(0)" ::: "memory");
            const unsigned og = xb_add(&bar[XB_TOP], 1u);
            const unsigned tg = og / nx;
            if (og + 1u == (tg + 1u) * nx) xb_add(&bar[XB_TOPGEN], 1u);
            else XB_SPIN(xb_ld(&bar[XB_TOPGEN]) == tg, bar);
            __builtin_amdgcn_fence(__ATOMIC_ACQUIRE, "agent");
            xb_add(&bar[XB_XGEN(b.x)], 1u);
            asm volatile("s_waitcnt vmcnt(0)" ::: "memory");
        } else {
            XB_SPIN(xb_ld(&bar[XB_XGEN(b.x)]) == gen, bar);
            __builtin_amdgcn_fence(__ATOMIC_ACQUIRE, "agent");
            asm volatile("s_waitcnt vmcnt(0)" ::: "memory");
        }
    }
    __syncthreads();
}

__device__ __forceinline__ void transpose_item(const float* W, int K, int Nsrc, const float* g, bf16* Bt, int n0, int src0, int nvalid, int k0, LAS float* scr, int lane) {
    { const int n = lane & 31, kh = lane >> 5; const bool ok = n < nvalid; const float* wp = W + (size_t)(k0 + kh) * Nsrc + src0 + n; float v[32];
#pragma unroll
      for (int i = 0; i < 32; ++i) v[i] = ok ? wp[(size_t)(2 * i) * Nsrc] : 0.f;
      if (g) {
#pragma unroll
        for (int i = 0; i < 32; ++i) v[i] *= g[k0 + 2 * i + kh]; }
#pragma unroll
      for (int i = 0; i < 32; ++i) scr[(2 * i + kh) * 33 + n] = v[i]; }
    asm volatile("s_waitcnt lgkmcnt(0)" ::: "memory");
    const int c = lane & 7;
#pragma unroll
    for (int j = 0; j < 4; ++j) { const int n = (lane >> 3) + 8 * j; const LAS float* s = scr + (8 * c) * 33 + n;
        v4u o; o.x = pk2(s[0 * 33], s[1 * 33]); o.y = pk2(s[2 * 33], s[3 * 33]); o.z = pk2(s[4 * 33], s[5 * 33]); o.w = pk2(s[6 * 33], s[7 * 33]);
        *(v4u*)(Bt + (size_t)(n0 + n) * K + k0 + 8 * c) = o; }
    asm volatile("s_waitcnt lgkmcnt(0)" ::: "memory");
}
__device__ __forceinline__ void granule_map(int mode, int gr, int& src0, int& nvalid) {
    const int n0 = gr * 32; nvalid = 32;
    if (mode == 0) { src0 = n0; return; }
    const int tile = n0 >> 8, L = n0 & 255;
    if (mode == 1) { src0 = (L < 128) ? (128 * tile + L) : (DFF + 128 * tile + (L - 128)); return; }
    const int a = 64 * ((L >> 5) & 3) + 32 * (L >> 7);
    const int lc = 256 * tile + a;
    if (mode == 2) { src0 = lc; return; }
    if (lc < 3 * MIXW) { src0 = lc; return; }
    if (lc < 3 * MIXW + MEMW) { src0 = lc + NH; return; }
    if (lc == 3 * MIXW + MEMW) { src0 = 3 * MIXW; nvalid = NH; return; }
    src0 = 0; nvalid = 0;
}
__device__ __forceinline__ void convert_weight(const float* W, int K, int Nsrc, int Ndst, const float* g, bf16* Bt, int mode, LAS float* scr, int lane, int gw, int NGW) {
    const int nk = K / 64, ngr = Ndst / 32, items = nk * ngr;
    for (int it = gw; it < items; it += NGW) { const int gr = it % ngr, kb = it / ngr; int src0, nvalid; granule_map(mode, gr, src0, nvalid);
        transpose_item(W, K, Nsrc, g, Bt, gr * 32, src0, nvalid, kb * 64, scr, lane); }
}
__device__ __forceinline__ void row_to_bf16_ssq(const float* xrow, bf16* orow, float* ssqrow, int lane) {
    const f32x4* xr = (const f32x4*)xrow + lane; f32x4 v[4]; float s = 0.f;
#pragma unroll
    for (int j = 0; j < 4; ++j) { v[j] = xr[64 * j]; s += (v[j][0] * v[j][0] + v[j][1] * v[j][1]) + (v[j][2] * v[j][2] + v[j][3] * v[j][3]); }
    s = wave_sum(s);
    v2u* o8 = (v2u*)orow + lane;
#pragma unroll
    for (int j = 0; j < 4; ++j) { v2u w; w.x = pk2(v[j][0], v[j][1]); w.y = pk2(v[j][2], v[j][3]); o8[64 * j] = w; }
    if (lane < 4) ssqrow[lane] = (lane == 0) ? s : 0.f;
}

namespace lru {
constexpr int XCS = 68;
constexpr int XC_BYTES = 32 * XCS * 4;
constexpr int OFF_WS = NWAVES * XC_BYTES;
constexpr int OFF_CARRY = OFF_WS + NWAVES * 64 * 2 * 4;
__device__ __forceinline__ int crow(int r, int hi) { return (r & 3) + 8 * (r >> 2) + 4 * hi; }
__device__ __forceinline__ float sigm(float x) { return __builtin_amdgcn_rcpf(1.0f + __builtin_amdgcn_exp2f(-x * LOG2E)); }

template <bool FUSED> __device__ __forceinline__ void unit_a(int b, int h, int c, const bf16* P, const float* conv_w, const float* conv_b, const bf16* WrgT, const bf16* WigT,
                                       const float* b_rg, const float* b_ig, const float* lam, bf16* cat, bf16* AL, float* summ, unsigned* flags, LAS unsigned char* lds) {
    int tid_ = threadIdx.x; asm volatile("" : "+v"(tid_)); const int tid = tid_, lane = tid & 63, r32 = lane & 31, hi = lane >> 5; const int w = __builtin_amdgcn_readfirstlane(tid >> 6);
    const int t0 = c * 256 + w * 32; const long row0 = (long)b * SEQ + t0;
    LAS float* xc = (LAS float*)(lds + w * XC_BYTES);
    bf16x8 afr[4];
#pragma unroll
    for (int kk = 0; kk < 4; ++kk) {
        const int ch0 = 16 * kk + 8 * hi, gch = h * HD + ch0;
        f32x4 a0 = *(const f32x4*)(conv_b + gch), a1 = *(const f32x4*)(conv_b + gch + 4);
#pragma unroll
        for (int tap = 0; tap < 4; ++tap) {
            const int tt = t0 + r32 - 3 + tap;
            if (tt >= 0) {
                const v4u xv = *(const v4u*)(P + (size_t)(row0 + r32 - 3 + tap) * N_LRU + gch);
                const f32x4 w0 = *(const f32x4*)(conv_w + tap * MIXW + gch), w1 = *(const f32x4*)(conv_w + tap * MIXW + gch + 4);
                a0[0] += w0[0] * bf_lo(xv.x); a0[1] += w0[1] * bf_hi(xv.x); a0[2] += w0[2] * bf_lo(xv.y); a0[3] += w0[3] * bf_hi(xv.y);
                a1[0] += w1[0] * bf_lo(xv.z); a1[1] += w1[1] * bf_hi(xv.z); a1[2] += w1[2] * bf_lo(xv.w); a1[3] += w1[3] * bf_hi(xv.w);
            }
        }
        *(LAS f32x4*)(xc + r32 * XCS + ch0) = a0; *(LAS f32x4*)(xc + r32 * XCS + ch0 + 4) = a1;
        v4u pk; pk.x = pk2(a0[0], a0[1]); pk.y = pk2(a0[2], a0[3]); pk.z = pk2(a1[0], a1[1]); pk.w = pk2(a1[2], a1[3]);
        afr[kk] = __builtin_bit_cast(bf16x8, pk);
    }
    f32x16 acc[2][2];
#pragma unroll
    for (int g = 0; g < 2; ++g)
#pragma unroll
        for (int jt = 0; jt < 2; ++jt) { f32x16 z = {}; const bf16* WT = (g == 0 ? WrgT : WigT) + (size_t)((h * HD + 32 * jt + r32) * HD + 8 * hi);
#pragma unroll
            for (int kk = 0; kk < 4; ++kk) { const bf16x8 bfr = *(const bf16x8*)(WT + 16 * kk); z = __builtin_amdgcn_mfma_f32_32x32x16_bf16(afr[kk], bfr, z, 0, 0, 0); }
            acc[g][jt] = z; }
    asm volatile("s_waitcnt lgkmcnt(0)" ::: "memory"); __builtin_amdgcn_wave_barrier();
#pragma unroll
    for (int jt = 0; jt < 2; ++jt) {
        const int gch = h * HD + 32 * jt + r32;
        const float brg = b_rg[gch], big = b_ig[gch], sp = log1pf(expf(-lam[gch]));
#pragma unroll
        for (int r = 0; r < 16; ++r) {
            const float xcv = xc[crow(r, hi) * XCS + 32 * jt + r32];
            const float rg = sigm(acc[0][jt][r] + brg), ig = sigm(acc[1][jt][r] + big);
            const float la = -8.0f * rg * sp, a = __builtin_amdgcn_exp2f(la * LOG2E);
            const float x2 = 2.0f * la;
            const float em = (x2 > -0.25f) ? x2 * (1.0f + x2 * 0.5f * (1.0f + x2 * (1.0f / 3.0f) * (1.0f + x2 * 0.25f * (1.0f + x2 * 0.2f)))) : (a * a - 1.0f);
            acc[0][jt][r] = a; acc[1][jt][r] = __builtin_sqrtf(fmaxf(-em, 0.f)) * ig * xcv;
        }
    }
    asm volatile("s_waitcnt lgkmcnt(0)" ::: "memory"); __builtin_amdgcn_wave_barrier();
    LAS float* wsA = (LAS float*)(lds + OFF_WS);
#pragma unroll
    for (int jt = 0; jt < 2; ++jt) {
        float AG[4], HG[4];
#pragma unroll
        for (int q = 0; q < 4; ++q) { float A = 1.f, H = 0.f;
#pragma unroll
            for (int i = 0; i < 4; ++i) { const int r = 4 * q + i; const float a = acc[0][jt][r], bx = acc[1][jt][r]; H = a * H + bx; A = A * a; acc[1][jt][r] = H; acc[0][jt][r] = A; }
            AG[q] = A; HG[q] = H; }
        float Ac = 1.f, Hc = 0.f, cinA[4], cinH[4];
#pragma unroll
        for (int q = 0; q < 4; ++q) {
            const float pA = __shfl_xor(AG[q], 32), pH = __shfl_xor(HG[q], 32);
            const float fA = hi ? pA : AG[q], fH = hi ? pH : HG[q], sA = hi ? AG[q] : pA, sH = hi ? HG[q] : pH;
            const float A0 = Ac, H0 = Hc;
            Hc = fA * Hc + fH; Ac = Ac * fA;
            cinA[q] = hi ? Ac : A0; cinH[q] = hi ? Hc : H0;
            Hc = sA * Hc + sH; Ac = Ac * sA;
        }
#pragma unroll
        for (int r = 0; r < 16; ++r) { const int q = r >> 2; acc[1][jt][r] += acc[0][jt][r] * cinH[q]; acc[0][jt][r] *= cinA[q]; }
        if (hi == 0) { wsA[(w * 64 + 32 * jt + r32) * 2 + 0] = Ac; wsA[(w * 64 + 32 * jt + r32) * 2 + 1] = Hc; }
    }
    __syncthreads();
#pragma unroll
    for (int jt = 0; jt < 2; ++jt) {
        const int ch = 32 * jt + r32; float Ain = 1.f, Hin = 0.f, At = 1.f, Ht = 0.f;
#pragma unroll
        for (int w2 = 0; w2 < NWAVES; ++w2) { const float A = wsA[(w2 * 64 + ch) * 2 + 0], H = wsA[(w2 * 64 + ch) * 2 + 1];
            if (w2 == w) { Ain = At; Hin = Ht; }
            Ht = A * Ht + H; At = At * A; }
        if (w == NWAVES - 1 && hi == 0) {
            if (FUSED) { unsigned long long* sp = (unsigned long long*)summ + (size_t)((b * NH + h) * 16 + c) * 64;
                __hip_atomic_store(sp + ch, ((unsigned long long)__float_as_uint(Ht) << 32) | __float_as_uint(At), __ATOMIC_RELAXED, __HIP_MEMORY_SCOPE_AGENT); }
            else { float* sp = summ + (size_t)(((b * NH + h) * 16 + c) * 2) * 64; sp[ch] = At; sp[64 + ch] = Ht; } }
#pragma unroll
        for (int r = 0; r < 16; ++r) { acc[1][jt][r] += acc[0][jt][r] * Hin; acc[0][jt][r] *= Ain; }
    }
    LAS bf16* stg = (LAS bf16*)xc;
#pragma unroll
    for (int jt = 0; jt < 2; ++jt)
#pragma unroll
        for (int r = 0; r < 16; ++r) { const int tt = crow(r, hi), ch = 32 * jt + r32; stg[tt * 64 + ch] = (bf16)f2bf(acc[1][jt][r]); stg[2048 + tt * 64 + ch] = (bf16)f2bf(acc[0][jt][r]); }
    asm volatile("s_waitcnt lgkmcnt(0)" ::: "memory"); __builtin_amdgcn_wave_barrier();
    if (!FUSED) {
#pragma unroll
        for (int i = 0; i < 4; ++i) { const int row = i * 8 + (lane >> 3), chk = lane & 7;
            const v4u hv = *(const LAS v4u*)(stg + row * 64 + chk * 8), av = *(const LAS v4u*)(stg + 2048 + row * 64 + chk * 8);
            *(v4u*)(cat + (size_t)(row0 + row) * DM + h * HD + chk * 8) = hv;
            *(v4u*)(AL + (size_t)(row0 + row) * MIXW + h * HD + chk * 8) = av; }
        __syncthreads();
        return;
    }
    const int ubase = (b * NH + h) * 16;
    if (w == NWAVES - 1) { asm volatile("s_waitcnt vmcnt(0)" ::: "memory"); if (lane == 0) __hip_atomic_store(flags + ubase + c, 1u, __ATOMIC_RELAXED, __HIP_MEMORY_SCOPE_AGENT); }
    v4u gv[4];
#pragma unroll
    for (int i = 0; i < 4; ++i) { const int row = i * 8 + (lane >> 3), chk = lane & 7; gv[i] = *(const v4u*)(P + (size_t)(row0 + row) * N_LRU + MIXW + h * HD + chk * 8); }
    if (tid < c) { unsigned sp = 0; while (__hip_atomic_load(flags + ubase + tid, __ATOMIC_RELAXED, __HIP_MEMORY_SCOPE_AGENT) == 0u) { __builtin_amdgcn_s_sleep(1); if (++sp > (1u << 22)) break; } }
    __builtin_amdgcn_fence(__ATOMIC_ACQUIRE, "agent");
    __syncthreads();
    LAS float* carry = (LAS float*)(lds + OFF_CARRY);
    if (tid < 64) { float Hc = 0.f; const unsigned long long* sp = (const unsigned long long*)summ + (size_t)ubase * 64 + tid;
        for (int c2 = 0; c2 < c; ++c2) { const unsigned long long wv = __hip_atomic_load(sp + c2 * 64, __ATOMIC_RELAXED, __HIP_MEMORY_SCOPE_AGENT); Hc = __uint_as_float((unsigned)wv) * Hc + __uint_as_float((unsigned)(wv >> 32)); }
        carry[tid] = Hc; }
    __syncthreads();
#pragma unroll
    for (int i = 0; i < 4; ++i) { const int row = i * 8 + (lane >> 3), chk = lane & 7;
        const v4u hv = *(const LAS v4u*)(stg + row * 64 + chk * 8), av = *(const LAS v4u*)(stg + 2048 + row * 64 + chk * 8);
        const f32x4 c0 = *(const LAS f32x4*)(carry + chk * 8), c1 = *(const LAS f32x4*)(carry + chk * 8 + 4);
        float o[8];
#define LRU_B1(k, hw, aw, gw_, cc) { const float hh = hw + aw * cc; const float gg = gw_; const float u2 = 1.5957691216f * (gg + 0.044715f * gg * gg * gg); o[k] = hh * gg * sigm(u2); }
        LRU_B1(0, bf_lo(hv.x), bf_lo(av.x), bf_lo(gv[i].x), c0[0]) LRU_B1(1, bf_hi(hv.x), bf_hi(av.x), bf_hi(gv[i].x), c0[1])
        LRU_B1(2, bf_lo(hv.y), bf_lo(av.y), bf_lo(gv[i].y), c0[2]) LRU_B1(3, bf_hi(hv.y), bf_hi(av.y), bf_hi(gv[i].y), c0[3])
        LRU_B1(4, bf_lo(hv.z), bf_lo(av.z), bf_lo(gv[i].z), c1[0]) LRU_B1(5, bf_hi(hv.z), bf_hi(av.z), bf_hi(gv[i].z), c1[1])
        LRU_B1(6, bf_lo(hv.w), bf_lo(av.w), bf_lo(gv[i].w), c1[2]) LRU_B1(7, bf_hi(hv.w), bf_hi(av.w), bf_hi(gv[i].w), c1[3])
#undef LRU_B1
        v4u ov; ov.x = pk2(o[0], o[1]); ov.y = pk2(o[2], o[3]); ov.z = pk2(o[4], o[5]); ov.w = pk2(o[6], o[7]);
        *(v4u*)(cat + (size_t)(row0 + row) * DM + h * HD + chk * 8) = ov; }
    __syncthreads();
}
__device__ __forceinline__ void unit_b(int b, int h, int c, const bf16* P, const bf16* AL, const float* summ, bf16* cat, LAS unsigned char* lds) {
    int tid_ = threadIdx.x; asm volatile("" : "+v"(tid_)); const int tid = tid_; LAS float* carry = (LAS float*)(lds + OFF_CARRY);
    if (tid < 64) { float Hc = 0.f; const float* sp = summ + (size_t)((b * NH + h) * 16) * 2 * 64;
        for (int c2 = 0; c2 < c; ++c2) { const float A = sp[c2 * 128 + tid], H = sp[c2 * 128 + 64 + tid]; Hc = A * Hc + H; }
        carry[tid] = Hc; }
    __syncthreads();
    const long R0 = (long)b * SEQ + c * 256;
#pragma unroll
    for (int i = 0; i < 4; ++i) { const int idx = tid + 512 * i, row = idx >> 3, chk = idx & 7;
        bf16* cp = cat + (size_t)(R0 + row) * DM + h * HD + chk * 8;
        const v4u hv = *(const v4u*)cp, av = *(const v4u*)(AL + (size_t)(R0 + row) * MIXW + h * HD + chk * 8), gv = *(const v4u*)(P + (size_t)(R0 + row) * N_LRU + MIXW + h * HD + chk * 8);
        const f32x4 c0 = *(const LAS f32x4*)(carry + chk * 8), c1 = *(const LAS f32x4*)(carry + chk * 8 + 4);
        float o[8];
#define LRU_B1(k, hw, aw, gw_, cc) { const float hh = hw + aw * cc; const float gg = gw_; const float u2 = 1.5957691216f * (gg + 0.044715f * gg * gg * gg); o[k] = hh * gg * sigm(u2); }
        LRU_B1(0, bf_lo(hv.x), bf_lo(av.x), bf_lo(gv.x), c0[0]) LRU_B1(1, bf_hi(hv.x), bf_hi(av.x), bf_hi(gv.x), c0[1])
        LRU_B1(2, bf_lo(hv.y), bf_lo(av.y), bf_lo(gv.y), c0[2]) LRU_B1(3, bf_hi(hv.y), bf_hi(av.y), bf_hi(gv.y), c0[3])
        LRU_B1(4, bf_lo(hv.z), bf_lo(av.z), bf_lo(gv.z), c1[0]) LRU_B1(5, bf_hi(hv.z), bf_hi(av.z), bf_hi(gv.z), c1[1])
        LRU_B1(6, bf_lo(hv.w), bf_lo(av.w), bf_lo(gv.w), c1[2]) LRU_B1(7, bf_hi(hv.w), bf_hi(av.w), bf_hi(gv.w), c1[3])
#undef LRU_B1
        v4u ov; ov.x = pk2(o[0], o[1]); ov.y = pk2(o[2], o[3]); ov.z = pk2(o[4], o[5]); ov.w = pk2(o[6], o[7]);
        *(v4u*)cp = ov; }
    __syncthreads();
}
}

__device__ __forceinline__ void fgate_unit(int u, const bf16* hb, const bf16* Wf, const float* ssq, const float* bf, float* logf) {
    int tid_ = threadIdx.x; asm volatile("" : "+v"(tid_)); const int lane = tid_ & 63, r32 = lane & 31, hi = lane >> 5; const int w = __builtin_amdgcn_readfirstlane(tid_ >> 6);
    if (w >= 4) return;
    const int row0 = u * 128 + w * 32;
    const bf16* ap = hb + (size_t)(row0 + r32) * DM + 8 * hi; const bf16* bp = Wf + (size_t)r32 * DM + 8 * hi;
    f32x16 acc = {};
#pragma unroll 8
    for (int kk = 0; kk < 64; ++kk) { const bf16x8 a = *(const bf16x8*)(ap + 16 * kk), b = *(const bf16x8*)(bp + 16 * kk); acc = __builtin_amdgcn_mfma_f32_32x32x16_bf16(a, b, acc, 0, 0, 0); }
    if (r32 < NH) { const float bfe = bf[r32];
#pragma unroll
        for (int r = 0; r < 16; ++r) { const int row = row0 + (r & 3) + 8 * (r >> 2) + 4 * hi; const f32x4 p = *(const f32x4*)(ssq + (size_t)row * 4);
            const float rs = __builtin_amdgcn_rsqf(((p[0] + p[1]) + (p[2] + p[3])) * (1.0f / 1024.0f) + 1e-6f);
            const float x = acc[r] * rs + bfe; const float ls = fminf(x, 0.f) - log1pf(__expf(-fabsf(x)));
            logf[(size_t)((row >> 12) * NH + r32) * SEQ + (row & 4095)] = ls; } }
}

__device__ __forceinline__ void cumsum_unit(const float* logf, float* ck2, int s, LAS unsigned char* lds) {
    int tid_ = threadIdx.x; asm volatile("" : "+v"(tid_)); const int tid = tid_, lane = tid & 63, w = tid >> 6; LAS float* wt = (LAS float*)lds;
    const f32x4* src = (const f32x4*)(logf + (size_t)s * SEQ) + tid * 2; f32x4 a = src[0], b = src[1];
    a[1] += a[0]; a[2] += a[1]; a[3] += a[2]; b[0] += a[3]; b[1] += b[0]; b[2] += b[1]; b[3] += b[2];
    float tot = b[3], inc = tot;
#pragma unroll
    for (int o = 1; o < 64; o <<= 1) { const float t = __shfl_up(inc, o); if (lane >= o) inc += t; }
    if (lane == 63) wt[w] = inc;
    __syncthreads();
    float off = inc - tot;
    for (int w2 = 0; w2 < w; ++w2) off += wt[w2];
    f32x4* dst = (f32x4*)(ck2 + (size_t)s * SEQ) + tid * 2;
    dst[0] = (a + off) * LOG2E; dst[1] = (b + off) * LOG2E;
    __syncthreads();
}

__device__ __forceinline__ const float* inp(int i) { unsigned off = (unsigned)i * 8u; asm volatile("" : "+s"(off));
    return *(const float* const __attribute__((address_space(4)))*)((const __attribute__((address_space(4))) char*)__builtin_amdgcn_kernarg_segment_ptr() + off); }
#define IN_x inp(0)
#define IN_mem inp(1)
#define IN_mem_norm_g inp(2)
#define IN_mem_w_kv inp(3)
#define IN_mem_k_norm_g inp(4)
#define IN_ffn1_norm_g inp(5)
#define IN_ffn1_w_in inp(6)
#define IN_ffn1_w_out inp(7)
#define IN_mix_norm_g inp(8)
#define IN_mix_w_out inp(9)
#define IN_memq_norm_g inp(10)
#define IN_ffn2_norm_g inp(11)
#define IN_ffn2_w_in inp(12)
#define IN_ffn2_w_out inp(13)
#define IN_lru_w_in inp(14)
#define IN_lru_conv_w inp(15)
#define IN_lru_conv_b inp(16)
#define IN_lru_w_rg inp(17)
#define IN_lru_b_rg inp(18)
#define IN_lru_w_ig inp(19)
#define IN_lru_b_ig inp(20)
#define IN_lru_lambda inp(21)
#define IN_fox_w_in inp(22)
#define IN_fox_b_f inp(23)
#define IN_fox_q_norm_g inp(24)
#define IN_fox_k_norm_g inp(25)
#ifndef PROBE_DUP_G1
#define PROBE_DUP_G1 0
#endif
#ifndef PROBE_SYNCS
#define PROBE_SYNCS 0
#endif
#ifndef PROBE_DUP_PRO
#define PROBE_DUP_PRO 0
#endif
#ifndef PROBE_ATTN_BAND
#define PROBE_ATTN_BAND 0
#endif
#ifndef PROBE_ATTN_NOBIAS
#define PROBE_ATTN_NOBIAS 0
#endif
#ifndef PROBE_K
#define PROBE_K DM
#endif
#ifndef PROBE_PMASK
#define PROBE_PMASK (-1)
#define PROBE_NMASK (-1)
#endif
#ifndef PROBE_G1_LOCAL
#define PROBE_G1_LOCAL 0
#endif
#ifndef PG8_USE_SP2
#define PG8_USE_SP2 true
#endif
#ifndef PROBE_PLAIN_EPI
#define PROBE_PLAIN_EPI 0
#endif
#ifndef PROBE_CLOCK
#define PROBE_CLOCK 0
#endif
#ifndef LRU_FUSED
#define LRU_FUSED 1
#endif
#ifndef PROBE_DUP_MIX0
#define PROBE_DUP_MIX0 0
#endif
#ifndef PROBE_DUP_MIX
#define PROBE_DUP_MIX 0
#endif
struct Args { const float* in[26]; float* out; unsigned char* ws; };
__device__ __forceinline__ void fill_gtab(LAS float* gt, const float* g1, float s1, const float* g2, float s2, const float* g3, float s3, const float* bf) {
    int t = threadIdx.x; asm volatile("" : "+v"(t));
    if (t < 256) { const int r = t >> 6, e = t & 63; float v = 1.f;
        if (r == 0) { if (g1) v = g1[e] * s1; } else if (r == 1) { if (g2) v = g2[e] * s2; } else if (r == 2) { if (g3) v = g3[e] * s3; } else { v = (bf && e < 12) ? bf[e] : 0.f; }
        gt[t] = v; }
    __syncthreads();
}
#define PHASE_BEGIN int bxl = blockIdx.x, Gl = gridDim.x; asm volatile("" : "+s"(bxl), "+s"(Gl)); const int vcul = (Gl % 8 == 0) ? (bxl % 8) * (Gl / 8) + bxl / 8 : bxl; unsigned char* const wsl = (unsigned char*)inp(27); (void)vcul; (void)wsl
#define WSP(T, off) ((T*)(wsl + (off)))
__global__ void __launch_bounds__(NWAVES * 64, 2) mega_fwd(Args args) {
    extern __shared__ __attribute__((aligned(16))) unsigned char lds[];
    cg::grid_group grid = cg::this_grid();
    LAS unsigned char* L = (LAS unsigned char*)lds;
    {
        PHASE_BEGIN; const int tid = threadIdx.x;
        if (bxl == 0) for (int i = tid; i < XCD_BAR_WORDS; i += NWAVES * 64) ((unsigned*)wsl)[i] = 0u;
        if (bxl == 1 % Gl) for (int i = tid; i < BATCH * NH * 16; i += NWAVES * 64) WSP(unsigned, WS_FLAGS)[i] = 0u;
        if (tid < 2) ((volatile LAS unsigned*)(L + MISC_OFF))[tid] = 0u;
        __syncthreads();
    }
    for (int rep_ = 0; rep_ < 1 + PROBE_DUP_PRO; ++rep_) {
        PHASE_BEGIN; int tid_ = threadIdx.x; asm volatile("" : "+v"(tid_)); const int lane = tid_ & 63, wave = __builtin_amdgcn_readfirstlane(tid_ >> 6);
        LAS float* scr = (LAS float*)(L + wave * 16384);
        const int gw = vcul * NWAVES + wave, NGW = Gl * NWAVES;
#pragma unroll 1
        for (int s = 0; s < 4; ++s) { const int l = s >> 1, f = s & 1;
            const float* win = (f ? IN_ffn2_w_in : IN_ffn1_w_in) + (size_t)l * DM * 2 * DFF; const float* wout = (f ? IN_ffn2_w_out : IN_ffn1_w_out) + (size_t)l * DFF * DM; const float* g = (f ? IN_ffn2_norm_g : IN_ffn1_norm_g) + l * DM;
            convert_weight(win, DM, 2 * DFF, 2 * DFF, g, (bf16*)(wsl + WS_W1 + s * W1_BYTES), 1, scr, lane, gw, NGW);
            convert_weight(wout, DFF, DM, DM, nullptr, (bf16*)(wsl + WS_W2 + s * W2_BYTES), 0, scr, lane, gw, NGW); }
        convert_weight(IN_lru_w_in, DM, N_LRU, N_LRU, IN_mix_norm_g, WSP(bf16, WS_WLRU), 2, scr, lane, gw, NGW);
        convert_weight(IN_fox_w_in, DM, N_FOX_SRC, N_FOX, IN_mix_norm_g + DM, WSP(bf16, WS_WFOX), 3, scr, lane, gw, NGW);
        convert_weight(IN_mix_w_out, DM, DM, DM, nullptr, WSP(bf16, WS_WOUT0), 0, scr, lane, gw, NGW);
        convert_weight(IN_mix_w_out + (size_t)DM * DM, DM, DM, DM, nullptr, WSP(bf16, WS_WOUT1), 0, scr, lane, gw, NGW);
        convert_weight(IN_mem_w_kv, DM, 2 * MEMW, 2 * MEMW, IN_mem_norm_g, WSP(bf16, WS_WKV), 2, scr, lane, gw, NGW);
        { const float* wrg = IN_lru_w_rg; const float* wig = IN_lru_w_ig; bf16* WrgT = WSP(bf16, WS_WRG); bf16* WigT = WSP(bf16, WS_WIG);
          for (int e = gw * 64 + lane; e < NH * HD * HD; e += NGW * 64) { const int hh = e / (HD * HD), j = (e / HD) % HD, i = e % HD;
            WrgT[e] = (bf16)f2bf(wrg[(hh * HD + i) * HD + j]); WigT[e] = (bf16)f2bf(wig[(hh * HD + i) * HD + j]); } }
        { const float* x = IN_x; bf16* hb = WSP(bf16, WS_HB); float* ssq = WSP(float, WS_SSQ);
          for (int m = gw; m < M; m += NGW) row_to_bf16_ssq(x + (size_t)m * DM, hb + (size_t)m * DM, ssq + (size_t)m * 4, lane); }
        { const float* mem = IN_mem; bf16* memb = WSP(bf16, WS_MEMB); float* ssqm = WSP(float, WS_SSQM);
          for (int m = gw; m < MROWS; m += NGW) row_to_bf16_ssq(mem + (size_t)m * DM, memb + (size_t)m * DM, ssqm + (size_t)m * 4, lane); }
    }
    grid.sync();
    const XcdBarrier bar = xcd_barrier_post((unsigned*)inp(27), (volatile LAS unsigned*)(L + MISC_OFF));

#pragma unroll 1
    for (int layer_ = 0; layer_ < 2; ++layer_) {
#pragma unroll 1
        for (int f_ = 0; f_ < 2; ++f_) {
            int layer = layer_, f = f_; asm volatile("" : "+s"(layer), "+s"(f));
            if (f == 1) {
                { PHASE_BEGIN;
                  const float* mq = IN_memq_norm_g;
                  if (layer) fill_gtab((LAS float*)(L + GT_OFF), IN_fox_q_norm_g, C2, IN_fox_k_norm_g, 1.f, mq + HD, C2, IN_fox_b_f);
                  else fill_gtab((LAS float*)(L + GT_OFF), mq, C2, nullptr, 1.f, nullptr, 1.f, nullptr);
                  pg8::Gemm g{WSP(bf16, WS_HB), layer ? WSP(bf16, WS_WFOX) : WSP(bf16, WS_WLRU), M, layer ? N_FOX_GEMM : N_LRU, DM}; pg8::RstdOrder S; S.init(M, layer ? N_FOX_GEMM : N_LRU, Gl, bxl); S.ssq = WSP(float, WS_SSQ); S.tab = (LAS float*)(L + RS_OFF);
                  pg8::EpiHead E = layer ? pg8::EpiHead{WSP(bf16, WS_R), N_FOX, (LAS float*)(L + RS_OFF), 0, 3, 3, 6, 9, 10, -1, (LAS float*)(L + GT_OFF), nullptr}
                                         : pg8::EpiHead{WSP(bf16, WS_R), N_LRU, (LAS float*)(L + RS_OFF), 6, 7, 0, 0, 0, 0, -1, (LAS float*)(L + GT_OFF), nullptr};
                  pg8::gemm_phase<pg8::EpiHead, pg8::RstdOrder, true, PG8_USE_SP2>(L, g, S, E); }
                if (layer == 0) {
                  PHASE_BEGIN; const int nfull = (M / 256 * (N_LRU / 256)) % Gl; const bool spread = (nfull > 0 && Gl - nfull >= 16);
                  const int c = spread ? ((bxl >= nfull && bxl < nfull + 16) ? bxl - nfull : (1 << 28)) : bxl;
                  fill_gtab((LAS float*)(L + GT_OFF), IN_mem_k_norm_g, 1.f, nullptr, 1.f, nullptr, 1.f, nullptr);
                  pg8::Gemm g{WSP(bf16, WS_MEMB), WSP(bf16, WS_WKV), MROWS, 2 * MEMW, DM}; pg8::RstdOrder S; S.init(MROWS, 2 * MEMW, spread ? 16 : Gl, c); S.ssq = WSP(float, WS_SSQM); S.tab = (LAS float*)(L + RS_OFF);
                  pg8::EpiHead E{WSP(bf16, WS_MEMKV), 2 * MEMW, (LAS float*)(L + RS_OFF), 0, 1, 0, 0, 0, 0, -1, (LAS float*)(L + GT_OFF), nullptr};
                  pg8::gemm_phase<pg8::EpiHead, pg8::RstdOrder, true, PG8_USE_SP2>(L, g, S, E); }
                if (layer) { PHASE_BEGIN;
                  for (int u = vcul; u < M / 128; u += Gl) fgate_unit(u, WSP(bf16, WS_HB), WSP(bf16, WS_WFOX) + (size_t)N_FOX_GEMM * DM, WSP(float, WS_SSQ), IN_fox_b_f, WSP(float, WS_LOGF)); }
                xcd_barrier(bar);
                if (layer == 0) {
                    for (int rep_ = 0; rep_ < 1 + PROBE_DUP_MIX + PROBE_DUP_MIX0; ++rep_) {
                    { PHASE_BEGIN;
                      for (int u = vcul; u < BATCH * NH * 16; u += Gl) { const int c = u & 15, bh = u >> 4;
                        lru::unit_a<LRU_FUSED != 0>(bh / NH, bh % NH, c, WSP(bf16, WS_R), IN_lru_conv_w, IN_lru_conv_b, WSP(bf16, WS_WRG), WSP(bf16, WS_WIG), IN_lru_b_rg, IN_lru_b_ig, IN_lru_lambda, WSP(bf16, WS_CAT), WSP(bf16, WS_R + R_AL), WSP(float, WS_SUMM), WSP(unsigned, WS_FLAGS), L); } }
                    { PHASE_BEGIN; bf16* R = WSP(bf16, WS_R); bf16* memKV = WSP(bf16, WS_MEMKV); bf16* cat = WSP(bf16, WS_CAT);
                      for (int u = vcul; u < BATCH * 4 * 16; u += Gl) { const int b = u >> 6, hm = (u >> 4) & 3, qb = u & 15;
                        attn_body::attn_unit<false, 24>((const attn_body::bf16*)(R + (size_t)(b * SEQ + qb * 256) * N_LRU + 2 * MIXW + hm * HD), N_LRU,
                            (const attn_body::bf16*)(memKV + (size_t)(b * NMEM) * 2 * MEMW + hm * HD), (const attn_body::bf16*)(memKV + (size_t)(b * NMEM) * 2 * MEMW + MEMW + hm * HD), 2 * MEMW,
                            (attn_body::bf16*)(cat + (size_t)(b * SEQ + qb * 256) * DM + MIXW + hm * HD), DM, 4, nullptr, (char*)lds); } }
                    }
#if !LRU_FUSED
                    xcd_barrier(bar);
                    { PHASE_BEGIN;
                      for (int u = vcul; u < BATCH * NH * 16; u += Gl) { const int c = u & 15, bh = u >> 4; lru::unit_b(bh / NH, bh % NH, c, WSP(bf16, WS_R), WSP(bf16, WS_R + R_AL), WSP(float, WS_SUMM), WSP(bf16, WS_CAT), L); } }
#endif
                    xcd_barrier(bar);
                } else {
                    { PHASE_BEGIN; for (int s = bxl; s < BATCH * NH; s += Gl) cumsum_unit(WSP(float, WS_LOGF), WSP(float, WS_CK), s, L); }
                    xcd_barrier(bar);
                    for (int rep_ = 0; rep_ < 1 + PROBE_DUP_MIX; ++rep_) {
                    { PHASE_BEGIN; bf16* R = WSP(bf16, WS_R); bf16* cat = WSP(bf16, WS_CAT); const float* ck2 = WSP(float, WS_CK);
                      for (int p = vcul; p < BATCH * NH * 8; p += Gl) { const int bh = p >> 3, s = p & 7, b = bh / NH, h = bh % NH;
#pragma unroll 1
                        for (int k = 0; k < 2; ++k) { const int qb = k ? 15 - s : s;
                            attn_body::attn_unit<true, 24>((const attn_body::bf16*)(R + (size_t)(b * SEQ + qb * 256) * N_FOX + h * HD), N_FOX,
                                (const attn_body::bf16*)(R + (size_t)(b * SEQ) * N_FOX + MIXW + h * HD), (const attn_body::bf16*)(R + (size_t)(b * SEQ) * N_FOX + 2 * MIXW + h * HD), N_FOX,
                                (attn_body::bf16*)(cat + (size_t)(b * SEQ + qb * 256) * DM + h * HD), DM, 4 * qb + 4, ck2 + (size_t)bh * SEQ, (char*)lds); } } }
#if PROBE_ATTN_NOBIAS
                    { PHASE_BEGIN; bf16* R = WSP(bf16, WS_R); bf16* dummy = WSP(bf16, WS_END); const float* ck2 = WSP(float, WS_CK);
                      for (int p = vcul; p < BATCH * NH * 8; p += Gl) { const int bh = p >> 3, s = p & 7, b = bh / NH, h = bh % NH;
#pragma unroll 1
                        for (int k = 0; k < 2; ++k) { const int qb = k ? 15 - s : s;
                            attn_body::attn_unit<true, 24, true>((const attn_body::bf16*)(R + (size_t)(b * SEQ + qb * 256) * N_FOX + h * HD), N_FOX,
                                (const attn_body::bf16*)(R + (size_t)(b * SEQ + (PROBE_ATTN_BAND ? qb * 256 : 0)) * N_FOX + MIXW + h * HD), (const attn_body::bf16*)(R + (size_t)(b * SEQ + (PROBE_ATTN_BAND ? qb * 256 : 0)) * N_FOX + 2 * MIXW + h * HD), N_FOX,
                                (attn_body::bf16*)(dummy + (size_t)(b * SEQ + qb * 256) * DM + h * HD), DM, PROBE_ATTN_BAND ? 4 : 4 * qb + 4, ck2 + (size_t)bh * SEQ, (char*)lds); } } }
#endif
                    { PHASE_BEGIN; bf16* R = WSP(bf16, WS_R); bf16* memKV = WSP(bf16, WS_MEMKV); bf16* cat = WSP(bf16, WS_CAT);
                      for (int u = vcul; u < BATCH * 4 * 16; u += Gl) { const int b = u >> 6, hm = (u >> 4) & 3, qb = u & 15;
                        attn_body::attn_unit<false, 24>((const attn_body::bf16*)(R + (size_t)(b * SEQ + qb * 256) * N_FOX + 3 * MIXW + hm * HD), N_FOX,
                            (const attn_body::bf16*)(memKV + (size_t)(b * NMEM) * 2 * MEMW + hm * HD), (const attn_body::bf16*)(memKV + (size_t)(b * NMEM) * 2 * MEMW + MEMW + hm * HD), 2 * MEMW,
                            (attn_body::bf16*)(cat + (size_t)(b * SEQ + qb * 256) * DM + MIXW + hm * HD), DM, 4, nullptr, (char*)lds); } }
                    }
                    xcd_barrier(bar);
                }
                { PHASE_BEGIN;
                  pg8::Gemm g{WSP(bf16, WS_CAT), (const bf16*)(wsl + (layer ? WS_WOUT1 : WS_WOUT0)), M, DM, DM}; pg8::StaticOrder S; S.init(M, DM, Gl, bxl);
                  pg8::EpiRes<false> E{WSP(bf16, WS_HB), nullptr, WSP(float, WS_SSQ), (LAS float*)(L + XS_OFF)};
                  pg8::gemm_phase<pg8::EpiRes<false>, pg8::StaticOrder, true, PG8_USE_SP2>(L, g, S, E); }
                xcd_barrier(bar);
            }
            const int s = layer * 2 + f;
#if PROBE_CLOCK
            if (s == PROBE_CLOCK - 1 && blockIdx.x == 0 && __builtin_amdgcn_readfirstlane(threadIdx.x >> 6) == 0) { unsigned long long* pc = (unsigned long long*)((unsigned char*)inp(27) + WS_FLAGS + 65536); pc[0] = clock64(); pc[1] = __builtin_amdgcn_s_memrealtime(); }
#endif
            { PHASE_BEGIN;
              pg8::Gemm g{WSP(bf16, WS_HB), (const bf16*)(wsl + WS_W1 + s * W1_BYTES), M, 2 * DFF, DM, -1, -1, WSP(unsigned, WS_FLAGS + 131072)}; pg8::RstdOrder S; S.init(M, 2 * DFF, Gl, bxl); S.ssq = WSP(float, WS_SSQ); S.tab = (LAS float*)(L + RS_OFF);
              pg8::EpiSwiglu E{WSP(bf16, WS_R), (LAS float*)(L + RS_OFF)};
              for (int rep_ = 0; rep_ < 1 + PROBE_DUP_G1; ++rep_) { pg8::gemm_phase<pg8::EpiSwiglu, pg8::RstdOrder, true, PG8_USE_SP2>(L, g, S, E); if (PROBE_DUP_G1) xcd_barrier(bar); } }
#if PROBE_CLOCK
            if (s == PROBE_CLOCK - 1 && blockIdx.x == 0 && __builtin_amdgcn_readfirstlane(threadIdx.x >> 6) == 0) { unsigned long long* pc = (unsigned long long*)((unsigned char*)inp(27) + WS_FLAGS + 65536); const unsigned long long t1 = clock64(), r1 = __builtin_amdgcn_s_memrealtime(); pc[2] = (t1 - pc[0]) * 100ull / (r1 - pc[1]); }
#endif
            xcd_barrier(bar);
            for (int rep_ = 0; rep_ < PROBE_SYNCS; ++rep_) xcd_barrier(bar);
            { PHASE_BEGIN; float* out = (float*)inp(26);
              pg8::Gemm g{WSP(bf16, WS_R), (const bf16*)(wsl + WS_W2 + s * W2_BYTES), M, DM, DFF}; pg8::StaticOrder S; S.init(M, DM, Gl, bxl);
              const bool last = (s == 3);
              pg8::EpiRes<true> E{WSP(bf16, WS_HB), last ? out : nullptr, WSP(float, WS_SSQ), (LAS float*)(L + XS_OFF)};
              pg8::gemm_phase<pg8::EpiRes<true>, pg8::StaticOrder, true, PG8_USE_SP2>(L, g, S, E); }
            if (s != 3) xcd_barrier(bar);
#if PROBE_G1_LOCAL
            { PHASE_BEGIN;
              int pk_ = PROBE_K; asm volatile("" : "+s"(pk_));
              pg8::Gemm g{WSP(bf16, WS_HB), (const bf16*)(wsl + WS_W1 + s * W1_BYTES), M, 2 * DFF, pk_, PROBE_PMASK, PROBE_NMASK, WSP(unsigned, WS_FLAGS + 131072)}; pg8::StaticOrder S; S.init(M, 2 * DFF, Gl, bxl);
#if PROBE_PLAIN_EPI
              pg8::EpiPlain E{WSP(bf16, WS_R)};
              pg8::gemm_phase<pg8::EpiPlain, pg8::StaticOrder, true, PG8_USE_SP2>(L, g, S, E); }
#else
              pg8::EpiSwiglu E{WSP(bf16, WS_R), (LAS float*)(L + RS_OFF)};
              pg8::gemm_phase<pg8::EpiSwiglu, pg8::StaticOrder, true, PG8_USE_SP2>(L, g, S, E); }
#endif
            xcd_barrier(bar);
#endif
        }
    }
#if PROBE_CLOCK
    if (blockIdx.x == 0 && __builtin_amdgcn_readfirstlane(threadIdx.x >> 6) == 0) { const unsigned long long* pc = (const unsigned long long*)((unsigned char*)inp(27) + WS_FLAGS + 65536); const unsigned long long mhz = pc[2] < 4000ull ? pc[2] : 4000ull;
        const unsigned long long r0 = __builtin_amdgcn_s_memrealtime(); while (__builtin_amdgcn_s_memrealtime() - r0 < mhz * 100ull) __builtin_amdgcn_s_sleep(8); }
#endif
}

extern "C" void kernel_launch(void* const* d_in, const int* in_sizes, int n_in, void* d_out, int out_size, void* d_ws, size_t ws_size, hipStream_t stream) {
    static int grid = 0;
    if (grid == 0) {
        if (n_in != 26 || in_sizes[0] != M * DM || out_size != M * DM || ws_size < WS_END) { fprintf(stderr, "kernel_launch: unexpected shapes (n_in %d, in0 %d, out %d, ws %zu)\n", n_in, n_in > 0 ? in_sizes[0] : -1, out_size, ws_size); grid = -1; return; }
        int dev = 0, cus = 0, per_cu = 0;
        if (hipGetDevice(&dev) != hipSuccess || hipDeviceGetAttribute(&cus, hipDeviceAttributeMultiprocessorCount, dev) != hipSuccess) { grid = -1; return; }
        if (hipFuncSetAttribute((const void*)mega_fwd, hipFuncAttributeMaxDynamicSharedMemorySize, LDS_BYTES) != hipSuccess) { fprintf(stderr, "kernel_launch: hipFuncSetAttribute failed\n"); grid = -1; return; }
        if (hipOccupancyMaxActiveBlocksPerMultiprocessor(&per_cu, (const void*)mega_fwd, NWAVES * 64, LDS_BYTES) != hipSuccess || per_cu < 1) { fprintf(stderr, "kernel_launch: occupancy query says %d\n", per_cu); per_cu = 1; }
        (void)hipGetLastError();
        grid = cus * 1;
    }
    if (grid < 0) return;
    Args a{};
    for (int i = 0; i < 26; ++i) a.in[i] = (const float*)d_in[i];
    a.out = (float*)d_out; a.ws = (unsigned char*)d_ws;
    void* params[] = {&a};
    hipError_t e = hipLaunchCooperativeKernel((const void*)mega_fwd, dim3(grid), dim3(NWAVES * 64), params, LDS_BYTES, stream);
    if (e != hipSuccess) fprintf(stderr, "kernel_launch: cooperative launch failed: %s (grid %d)\n", hipGetErrorString(e), grid);
}
```

```cpp
#include <hip/hip_runtime.h>
#include <cstdio>
#include <cstdint>
namespace pg8 {
#define PG8_LAS __attribute__((address_space(3)))
typedef unsigned short bf16_t;
typedef short bf16x8 __attribute__((ext_vector_type(8)));
typedef float f32x4 __attribute__((ext_vector_type(4)));
typedef unsigned u32x4 __attribute__((ext_vector_type(4)));
constexpr int BM = 256, BK = 64, HALF = 128, HTB = HALF * BK * 2  , STAGE_BYTES = 8 * HTB, NXCD = 8, WGM = 8;

__host__ __device__ __forceinline__ int lds_byte(int r, int c) { const int st = (r >> 4) * 2 + (c >> 5), rr = r & 15, cc = c & 31, ob = rr * 64 + cc * 2; return st * 1024 + (ob ^ (((ob >> 9) & 1) << 5)); }
__host__ __device__ __forceinline__ void stage_rc(int b, int& R, int& C) { const int st = b / 1024, sb = b % 1024, swz = sb ^ (((sb >> 9) & 1) << 5); R = (st >> 1) * 16 + swz / 64; C = (st & 1) * 32 + (swz % 64) / 2; }
__host__ __device__ __forceinline__ int perm32(int rho) { const int n = rho >> 4, i = rho & 15; return 8 * (i >> 2) + 4 * n + (i & 3); }

struct Unit { int pm, pn; };
struct Gemm { const bf16_t* A; const bf16_t* Bt; int M, N, K; };

struct StaticOrder {
    int nM, nN, nwg, G, c;
    __host__ __device__ void init(int M, int N, int G_, int c_) { nM = M / BM; nN = N / BM; nwg = nM * nN; G = G_; c = c_; }
    __host__ __device__ bool next(int i, Unit& u) const {
        const long L = (long)i * G + c; if (L >= nwg) return false;
        int wgid = (int)L; { const int q = nwg / NXCD, r = nwg % NXCD, xcd = wgid % NXCD, off = wgid / NXCD; wgid = (xcd < r ? xcd * (q + 1) : r * (q + 1) + (xcd - r) * q) + off; }
        const int nig = WGM * nN, gid = wgid / nig, fm = gid * WGM, gsz = (nM - fm) < WGM ? (nM - fm) : WGM;
        u.pm = fm + ((wgid % nig) % gsz); u.pn = (wgid % nig) / gsz; return true;
    }
    __device__ __forceinline__ void a_ready(const Unit&) const {}
    __device__ __forceinline__ void done(const Unit&) const {}
};

typedef float f32x2_cv __attribute__((ext_vector_type(2))); typedef __bf16 bf16x2_cv __attribute__((ext_vector_type(2)));
__device__ __forceinline__ unsigned cvt_pk_bf16(float lo, float hi) { f32x2_cv v = {lo, hi}; bf16x2_cv b = __builtin_convertvector(v, bf16x2_cv); return __builtin_bit_cast(unsigned, b); }
typedef float f32x2 __attribute__((ext_vector_type(2)));
constexpr float NORM_EPS_F = 1e-6f;
constexpr float LOG2E_F = 1.4426950408889634f;
__device__ __forceinline__ void rows_rstd(const float* ssq, int row0, float (&rs)[2][4]) {
    f32x4 p[2][4];
#pragma unroll
    for (int ai = 0; ai < 2; ++ai)
#pragma unroll
        for (int m = 0; m < 4; ++m) p[ai][m] = *(const f32x4*)(ssq + (size_t)(row0 + ai * HALF + m * 16) * 4);
#pragma unroll
    for (int ai = 0; ai < 2; ++ai)
#pragma unroll
        for (int m = 0; m < 4; ++m) rs[ai][m] = __builtin_amdgcn_rsqf(((p[ai][m][0] + p[ai][m][1]) + (p[ai][m][2] + p[ai][m][3])) * (1.0f / 1024.0f) + NORM_EPS_F);
    asm volatile("" ::: "memory");
}
__device__ __forceinline__ float fast_sigmoid(float x) { return __builtin_amdgcn_rcpf(1.0f + __builtin_amdgcn_exp2f(-x * LOG2E_F)); }

struct EpiSwiglu {
    static constexpr bool PERM = true, AFTER_DRAIN = false; static constexpr int ldc = 2816;
    bf16_t* O; const float* ssq;
    __device__ __forceinline__ void operator()(const f32x4 (&acc)[2][2][4][2], const Unit& u, int wr, int wc, int fr, int fq) const {
        const int row0 = u.pm * BM + wr * 64 + fr; const int col0 = u.pn * HALF + wc * 32 + 8 * fq;
        float rsv[2][4]; rows_rstd(ssq, row0, rsv);
#pragma unroll
        for (int ai = 0; ai < 2; ++ai)
#pragma unroll
            for (int m = 0; m < 4; ++m) { const int row = row0 + ai * HALF + m * 16; const float rs = rsv[ai][m];
                const float c1 = -rs * LOG2E_F, c2 = rs * rs;
                const f32x4 g0 = acc[ai][0][m][0], g1 = acc[ai][0][m][1], u0 = acc[ai][1][m][0], u1 = acc[ai][1][m][1];
                f32x4 t0 = g0 * c1, t1 = g1 * c1, p0 = (g0 * u0) * c2, p1 = (g1 * u1) * c2;
#pragma unroll
                for (int j = 0; j < 4; ++j) { t0[j] = __builtin_amdgcn_exp2f(t0[j]); t1[j] = __builtin_amdgcn_exp2f(t1[j]); }
                t0 = t0 + 1.0f; t1 = t1 + 1.0f;
#pragma unroll
                for (int j = 0; j < 4; ++j) { t0[j] = __builtin_amdgcn_rcpf(t0[j]); t1[j] = __builtin_amdgcn_rcpf(t1[j]); }
                const f32x4 v0 = p0 * t0, v1 = p1 * t1;
                u32x4 w; w.x = cvt_pk_bf16(v0[0], v0[1]); w.y = cvt_pk_bf16(v0[2], v0[3]); w.z = cvt_pk_bf16(v1[0], v1[1]); w.w = cvt_pk_bf16(v1[2], v1[3]);
                *(u32x4*)(O + (size_t)row * ldc + col0) = w; asm volatile("" ::: "memory"); }
    }
};

template <bool HALFSTEP> struct EpiRes {
    static constexpr bool PERM = true, AFTER_DRAIN = false; static constexpr float alpha = HALFSTEP ? 0.5f : 1.0f; static constexpr int ldc = 1024;
    bf16_t* hb; float* out; float* ssq; PG8_LAS float* xs;
    __device__ __forceinline__ void operator()(const f32x4 (&acc)[2][2][4][2], const Unit& u, int wr, int wc, int fr, int fq) const {
        const int row0 = u.pm * BM + wr * 64 + fr; const int col0 = u.pn * BM + wc * 32 + 8 * fq;
        u32x4 cur[2], nxt[2];
#pragma unroll
        for (int bj = 0; bj < 2; ++bj) cur[bj] = *(const u32x4*)(hb + (size_t)row0 * ldc + col0 + bj * HALF);
#pragma unroll
        for (int i = 0; i < 8; ++i) { const int ai = i >> 2, m = i & 3; const int row = row0 + ai * HALF + m * 16; const size_t off = (size_t)row * ldc + col0; float s = 0.f;
            if (i < 7) { const int rown = row0 + ((i + 1) >> 2) * HALF + ((i + 1) & 3) * 16;
#pragma unroll
                for (int bj = 0; bj < 2; ++bj) nxt[bj] = *(const u32x4*)(hb + (size_t)rown * ldc + col0 + bj * HALF); }
            asm volatile("" ::: "memory");
#pragma unroll
            for (int bj = 0; bj < 2; ++bj) { const u32x4 c = cur[bj]; f32x4 b0, b1;
                b0[0] = __builtin_bit_cast(float, c.x << 16); b0[1] = __builtin_bit_cast(float, c.x & 0xffff0000u); b0[2] = __builtin_bit_cast(float, c.y << 16); b0[3] = __builtin_bit_cast(float, c.y & 0xffff0000u);
                b1[0] = __builtin_bit_cast(float, c.z << 16); b1[1] = __builtin_bit_cast(float, c.z & 0xffff0000u); b1[2] = __builtin_bit_cast(float, c.w << 16); b1[3] = __builtin_bit_cast(float, c.w & 0xffff0000u);
                const f32x4 o0 = b0 + acc[ai][bj][m][0] * alpha, o1 = b1 + acc[ai][bj][m][1] * alpha;
                if (out) { *(f32x4*)(out + off + bj * HALF) = o0; *(f32x4*)(out + off + bj * HALF + 4) = o1; }
                else { u32x4 w; w.x = cvt_pk_bf16(o0[0], o0[1]); w.y = cvt_pk_bf16(o0[2], o0[3]); w.z = cvt_pk_bf16(o1[0], o1[1]); w.w = cvt_pk_bf16(o1[2], o1[3]);
                    *(u32x4*)(hb + off + bj * HALF) = w;
                    const float r0 = __builtin_bit_cast(float, w.x << 16), r1 = __builtin_bit_cast(float, w.x & 0xffff0000u), r2 = __builtin_bit_cast(float, w.y << 16), r3 = __builtin_bit_cast(float, w.y & 0xffff0000u);
                    const float r4 = __builtin_bit_cast(float, w.z << 16), r5 = __builtin_bit_cast(float, w.z & 0xffff0000u), r6 = __builtin_bit_cast(float, w.w << 16), r7 = __builtin_bit_cast(float, w.w & 0xffff0000u);
                    s += ((r0 * r0 + r1 * r1) + (r2 * r2 + r3 * r3)) + ((r4 * r4 + r5 * r5) + (r6 * r6 + r7 * r7)); } }
            if (!out) { s += __shfl_xor(s, 16); s += __shfl_xor(s, 32); if (fq == 0) xs[(ai * HALF + wr * 64 + m * 16 + fr) * 4 + wc] = s; }
            asm volatile("" ::: "memory");
#pragma unroll
            for (int bj = 0; bj < 2; ++bj) cur[bj] = nxt[bj];
        }
        if (!out) {
            asm volatile("s_waitcnt lgkmcnt(0)\n\ts_barrier" ::: "memory");
            int t = threadIdx.x; asm volatile("" : "+v"(t));
            if (t < 256) { const f32x4 v = *(const PG8_LAS f32x4*)(xs + t * 4); ssq[(size_t)(u.pm * BM + t) * 4 + u.pn] = (v[0] + v[1]) + (v[2] + v[3]); }
        }
    }
};

struct EpiHead {
    static constexpr bool PERM = true, AFTER_DRAIN = false;
    bf16_t* O; int ldc; const float* ssq;
    int lo1, hi1, lo2, hi2, lo3, hi3, logf_tile;
    const float *g1, *g2, *g3; float s1, s2, s3;
    const float* bf; float* logf;
    __device__ __forceinline__ void operator()(const f32x4 (&acc)[2][2][4][2], const Unit& u, int wr, int wc, int fr, int fq) const {
        const int row0 = u.pm * BM + wr * 64 + fr; const int pn = u.pn;
        if (pn == logf_tile) {
            if (wc == 0 && fq < 2) {
                float rsv[2][4]; rows_rstd(ssq, row0, rsv);
#pragma unroll
                for (int ai = 0; ai < 2; ++ai)
#pragma unroll
                    for (int m = 0; m < 4; ++m) { const int row = row0 + ai * HALF + m * 16; const float rs = rsv[ai][m]; const int b = row >> 12, t = row & 4095;
#pragma unroll
                        for (int n = 0; n < 2; ++n)
#pragma unroll
                            for (int j = 0; j < 4; ++j) { const int e = 8 * fq + 4 * n + j;
                                if (e < 12) { const float x = acc[ai][0][m][n][j] * rs + bf[e]; const float ls = fminf(x, 0.f) - log1pf(__expf(-fabsf(x))); logf[(size_t)(b * 12 + e) * 4096 + t] = ls; } } }
            }
            return;
        }
        const float* gn = nullptr; float sc = 1.f;
        if (pn >= lo1 && pn < hi1) { gn = g1; sc = s1; } else if (pn >= lo2 && pn < hi2) { gn = g2; sc = s2; } else if (pn >= lo3 && pn < hi3) { gn = g3; sc = s3; }
        f32x4 gv[2][2];
#pragma unroll
        for (int bj = 0; bj < 2; ++bj)
#pragma unroll
            for (int n = 0; n < 2; ++n) { if (gn) { gv[bj][n] = *(const f32x4*)(gn + 32 * bj + 8 * fq + 4 * n) * sc; } else gv[bj][n] = (f32x4){1.f, 1.f, 1.f, 1.f}; }
        const int col0 = pn * BM + wc * 64 + 8 * fq;
        float rsv[2][4]; rows_rstd(ssq, row0, rsv);
#pragma unroll
        for (int ai = 0; ai < 2; ++ai)
#pragma unroll
            for (int m = 0; m < 4; ++m) { const int row = row0 + ai * HALF + m * 16; const float rs = rsv[ai][m];
                f32x4 v[2][2]; float s = 0.f;
#pragma unroll
                for (int bj = 0; bj < 2; ++bj)
#pragma unroll
                    for (int n = 0; n < 2; ++n) { v[bj][n] = acc[ai][bj][m][n] * rs; s += (v[bj][n][0] * v[bj][n][0] + v[bj][n][1] * v[bj][n][1]) + (v[bj][n][2] * v[bj][n][2] + v[bj][n][3] * v[bj][n][3]); }
                float hs = 1.f;
                if (gn) { s += __shfl_xor(s, 16); s += __shfl_xor(s, 32); hs = __builtin_amdgcn_rsqf(s * (1.0f / 64.0f) + NORM_EPS_F); }
#pragma unroll
                for (int bj = 0; bj < 2; ++bj) { const f32x4 a = v[bj][0] * gv[bj][0] * hs, c = v[bj][1] * gv[bj][1] * hs;
                    u32x4 w; w.x = cvt_pk_bf16(a[0], a[1]); w.y = cvt_pk_bf16(a[2], a[3]); w.z = cvt_pk_bf16(c[0], c[1]); w.w = cvt_pk_bf16(c[2], c[3]);
                    *(u32x4*)(O + (size_t)row * ldc + col0 + 32 * bj) = w; }
                asm volatile("" ::: "memory"); }
    }
};

template <class Epi, class Sched, bool ALIGN_EPI = false, bool SP2 = false>
__device__ __forceinline__ void gemm_phase(PG8_LAS unsigned char* lds, const Gemm g, const Sched& S, const Epi& E) {
    int tid_ = threadIdx.x; asm volatile("" : "+v"(tid_)); const int tid = tid_, wid = __builtin_amdgcn_readfirstlane(tid >> 6), lane = tid & 63, wr = wid >> 2, wc = wid & 3, fr = lane & 15, fq = lane >> 4;
    const int K = g.K, nt = K / BK;
    unsigned voffA[2], voffB[2];
#pragma unroll
    for (int i = 0; i < 2; ++i) { int R, C; stage_rc(tid * 16 + i * 8192, R, C); const int Rb = Epi::PERM ? ((R & ~31) + perm32(R & 31)) : R;
        voffA[i] = (unsigned)(R * K + C) * 2u; voffB[i] = (unsigned)(Rb * K + C) * 2u; }
    const size_t kstep = (size_t)(BK * 2);
    const size_t hstep = (size_t)HALF * K * 2;
    const size_t tstep = 2 * hstep;
    const unsigned ldsw = (unsigned)wid * 1024u;
    const int aoff = lds_byte(wr * 64 + fr, fq * 8), boff = lds_byte(wc * 32 + fr, fq * 8);
#define PG8_SA(b, h) (((b) * 2 + (h)) * HTB)
#define PG8_SB(b, h) ((4 + (b) * 2 + (h)) * HTB)
#define PG8_STAGE(bufoff, gbase, voff) do { _Pragma("unroll") for (int _i = 0; _i < 2; ++_i) \
        __builtin_amdgcn_global_load_lds((const unsigned*)((const char*)(gbase) + (voff)[_i]), (PG8_LAS unsigned*)(lds + (bufoff) + ldsw + _i * 8192), 16, 0, 0); } while (0)
#define PG8_LDA(dst, b, h) do { _Pragma("unroll") for (int m = 0; m < 4; ++m) _Pragma("unroll") for (int k = 0; k < 2; ++k) dst[m][k] = *(const PG8_LAS bf16x8*)(lds + PG8_SA(b, h) + aoff + m * 2048 + k * 1024); } while (0)
#define PG8_LDB(dst, b, h) do { _Pragma("unroll") for (int n = 0; n < 2; ++n) _Pragma("unroll") for (int k = 0; k < 2; ++k) dst[n][k] = *(const PG8_LAS bf16x8*)(lds + PG8_SB(b, h) + boff + n * 2048 + k * 1024); } while (0)
#define PG8_MMA(ai, bj, At, Bt) do { __builtin_amdgcn_s_setprio(1); _Pragma("unroll") for (int m = 0; m < 4; ++m) _Pragma("unroll") for (int n = 0; n < 2; ++n) _Pragma("unroll") for (int k = 0; k < 2; ++k) \
        acc[ai][bj][m][n] = __builtin_amdgcn_mfma_f32_16x16x32_bf16(Bt[n][k], At[m][k], acc[ai][bj][m][n], 0, 0, 0); __builtin_amdgcn_s_setprio(0); } while (0)
#define PG8_WAIT_V(n) asm volatile("s_waitcnt vmcnt(" #n ")" ::: "memory")
#define PG8_WAIT_L(n) asm volatile("s_waitcnt lgkmcnt(" #n ")" ::: "memory")
#define PG8_BAR __builtin_amdgcn_s_barrier()
#define PG8_SCHED __builtin_amdgcn_sched_barrier(0)
    Unit cur, nxt; int ui = 0;
    if (!S.next(0, cur)) return;
    f32x4 acc[2][2][4][2];
#pragma unroll
    for (int a = 0; a < 2; ++a)
#pragma unroll
        for (int b = 0; b < 2; ++b)
#pragma unroll
            for (int m = 0; m < 4; ++m)
#pragma unroll
                for (int n = 0; n < 2; ++n) acc[a][b][m][n] = (f32x4){0.f, 0.f, 0.f, 0.f};
    bf16x8 At[4][2], B0[2][2], B1[2][2];
    const char* cA = (const char*)g.A + (size_t)cur.pm * tstep; const char* cB = (const char*)g.Bt + (size_t)cur.pn * tstep;
    S.a_ready(cur);
    if constexpr (SP2) {
        PG8_STAGE(PG8_SB(0, 0), cB, voffB); PG8_STAGE(PG8_SB(0, 1), cB + hstep, voffB); PG8_STAGE(PG8_SA(0, 0), cA, voffA); PG8_STAGE(PG8_SA(0, 1), cA + hstep, voffA);
        if (wr == 1) PG8_BAR;
        PG8_WAIT_V(2); PG8_BAR;
        PG8_STAGE(PG8_SB(1, 0), cB + kstep, voffB); PG8_STAGE(PG8_SA(1, 0), cA + kstep, voffA); PG8_STAGE(PG8_SB(1, 1), cB + hstep + kstep, voffB);
        PG8_WAIT_V(6); PG8_BAR;
    } else {
        PG8_STAGE(PG8_SB(0, 0), cB, voffB); PG8_STAGE(PG8_SA(0, 0), cA, voffA); PG8_STAGE(PG8_SB(0, 1), cB + hstep, voffB); PG8_STAGE(PG8_SA(0, 1), cA + hstep, voffA);
        if (wr == 1) PG8_BAR;
        PG8_WAIT_V(4); PG8_BAR;
        PG8_STAGE(PG8_SB(1, 0), cB + kstep, voffB); PG8_STAGE(PG8_SA(1, 0), cA + kstep, voffA); PG8_STAGE(PG8_SB(1, 1), cB + hstep + kstep, voffB);
        PG8_WAIT_V(6); PG8_BAR;
    }
    for (;;) {
        const bool has_next = S.next(ui + 1, nxt);
        const char* nA = has_next ? (const char*)g.A + (size_t)nxt.pm * tstep : cA; const char* nB = has_next ? (const char*)g.Bt + (size_t)nxt.pn * tstep : cB;
        for (int t = 0; t < nt; t += 2) {
            const bool last = (t == nt - 2);
            const char* a1 = cA + (size_t)(t + 1) * kstep;
            const char* a2 = last ? nA : cA + (size_t)(t + 2) * kstep; const char* b2 = last ? nB : cB + (size_t)(t + 2) * kstep;
            const char* a3 = a2 + kstep; const char* b3 = b2 + kstep;
            if (last && has_next) S.a_ready(nxt);
            if constexpr (SP2) {
            PG8_LDB(B0, 0, 0); PG8_LDB(B1, 0, 1); PG8_SCHED; PG8_LDA(At, 0, 0); PG8_STAGE(PG8_SA(1, 1), a1 + hstep, voffA);
            PG8_WAIT_V(8); PG8_WAIT_L(0); PG8_BAR; PG8_MMA(0, 0, At, B0); PG8_MMA(0, 1, At, B1); PG8_BAR; PG8_SCHED;
            PG8_LDA(At, 0, 1); PG8_STAGE(PG8_SB(0, 0), b2, voffB); PG8_STAGE(PG8_SB(0, 1), b2 + hstep, voffB); PG8_STAGE(PG8_SA(0, 0), a2, voffA);
            PG8_WAIT_V(8); PG8_WAIT_L(0); PG8_BAR; PG8_MMA(1, 0, At, B0); PG8_MMA(1, 1, At, B1); PG8_BAR; PG8_SCHED;
            PG8_LDB(B0, 1, 0); PG8_LDB(B1, 1, 1); PG8_SCHED; PG8_LDA(At, 1, 0); PG8_STAGE(PG8_SA(0, 1), a2 + hstep, voffA);
            PG8_WAIT_V(8); PG8_WAIT_L(0); PG8_BAR; PG8_MMA(0, 0, At, B0); PG8_MMA(0, 1, At, B1); PG8_BAR; PG8_SCHED;
            PG8_LDA(At, 1, 1); PG8_STAGE(PG8_SB(1, 0), b3, voffB); PG8_STAGE(PG8_SB(1, 1), b3 + hstep, voffB); PG8_STAGE(PG8_SA(1, 0), a3, voffA);
            PG8_WAIT_V(8); PG8_WAIT_L(0); PG8_BAR; PG8_MMA(1, 0, At, B0); PG8_MMA(1, 1, At, B1); PG8_BAR; PG8_SCHED;
            } else {
            PG8_LDB(B0, 0, 0); PG8_SCHED; PG8_LDA(At, 0, 0); PG8_STAGE(PG8_SA(1, 1), a1 + hstep, voffA);
            PG8_WAIT_L(8); PG8_BAR; PG8_WAIT_L(0); PG8_MMA(0, 0, At, B0); PG8_BAR; PG8_SCHED;
            PG8_LDB(B1, 0, 1); PG8_STAGE(PG8_SB(0, 0), b2, voffB);
            PG8_BAR; PG8_WAIT_L(0); PG8_MMA(0, 1, At, B1); PG8_BAR;
            PG8_LDA(At, 0, 1); PG8_STAGE(PG8_SA(0, 0), a2, voffA);
            PG8_BAR; PG8_WAIT_L(0); PG8_MMA(1, 0, At, B0); PG8_BAR; PG8_SCHED;
            PG8_STAGE(PG8_SB(0, 1), b2 + hstep, voffB);
            PG8_WAIT_V(6); PG8_BAR; PG8_MMA(1, 1, At, B1); PG8_BAR;
            PG8_LDB(B0, 1, 0); PG8_SCHED; PG8_LDA(At, 1, 0); PG8_STAGE(PG8_SA(0, 1), a2 + hstep, voffA);
            PG8_WAIT_L(8); PG8_BAR; PG8_WAIT_L(0); PG8_MMA(0, 0, At, B0); PG8_BAR; PG8_SCHED;
            PG8_LDB(B1, 1, 1); PG8_STAGE(PG8_SB(1, 0), b3, voffB);
            PG8_BAR; PG8_WAIT_L(0); PG8_MMA(0, 1, At, B1); PG8_BAR;
            PG8_LDA(At, 1, 1); PG8_STAGE(PG8_SA(1, 0), a3, voffA);
            PG8_BAR; PG8_WAIT_L(0); PG8_MMA(1, 0, At, B0); PG8_BAR; PG8_SCHED;
            PG8_STAGE(PG8_SB(1, 1), b3 + hstep, voffB);
            PG8_WAIT_V(6); PG8_BAR; PG8_MMA(1, 1, At, B1); PG8_BAR;
            }
        }
        if constexpr (ALIGN_EPI) { if (wr == 0) PG8_BAR; }
        if constexpr (!Epi::AFTER_DRAIN) { E(acc, cur, wr, wc, fr, fq); S.done(cur); }
        if (!has_next) break;
#pragma unroll
        for (int a = 0; a < 2; ++a)
#pragma unroll
            for (int b = 0; b < 2; ++b)
#pragma unroll
                for (int m = 0; m < 4; ++m)
#pragma unroll
                    for (int n = 0; n < 2; ++n) acc[a][b][m][n] = (f32x4){0.f, 0.f, 0.f, 0.f};
        cur = nxt; cA = nA; cB = nB; ++ui;
        if constexpr (ALIGN_EPI) { if (wr == 1) PG8_BAR; }
    }
    PG8_WAIT_V(0);
    if constexpr (!ALIGN_EPI) { if (wr == 0) PG8_BAR; }
    PG8_BAR;
    if constexpr (Epi::AFTER_DRAIN) { E.fused(acc, cur, wr, wc, fr, fq, lds, wid, lane); S.done(cur); }
#undef PG8_SA
#undef PG8_SB
#undef PG8_STAGE
#undef PG8_LDA
#undef PG8_LDB
#undef PG8_MMA
#undef PG8_WAIT_V
#undef PG8_WAIT_L
#undef PG8_BAR
#undef PG8_SCHED
}
}
#define PG8_SP2 true
#include <hip/hip_bf16.h>
#include <cmath>
namespace attn_body {
using bf16=__hip_bfloat16;
using bf16x8=__attribute__((ext_vector_type(8)))short;
using s16x4=__attribute__((ext_vector_type(4)))short;
using f32x16=__attribute__((ext_vector_type(16)))float;
using u32x4=__attribute__((ext_vector_type(4)))unsigned;
using f32x4v=__attribute__((ext_vector_type(4)))float;
constexpr int SEQ=4096,D=64;
constexpr int NW=8,QBLK=32,QB=QBLK*NW,KVBLK=64,NQB=SEQ/QB;
constexpr int ATTN_UNIT_ROWS=QB;
__device__ __forceinline__ int crow(int r,int hi){return (r&3)+8*(r>>2)+4*hi;}
#define SBAR() __builtin_amdgcn_sched_barrier(0)
__device__ __forceinline__ void cmask(f32x16&p0,f32x16&p1,int jb,int qrel,int hi){
  const float NEG=-INFINITY; int x=qrel-64*jb-4*hi; asm volatile("":"+v"(x));
  #pragma unroll
  for(int r=0;r<16;++r){const int c=(r&3)+8*(r>>2); if(c>x)p0[r]=NEG; if(c+32>x)p1[r]=NEG;}
}

constexpr int NSLOT=3, SLOTB=8192;
constexpr int LDS_K=0, LDS_V=NSLOT*SLOTB, LDS_WS=2*NSLOT*SLOTB, LDS_OST=LDS_WS+NW*64*4, LDS_CK=LDS_OST+NW*4096, LDS_BYTES=LDS_CK+SEQ*4;
constexpr float C2=0.125f*1.4426950408889634f;
__device__ __forceinline__ void glds16(const void*gsrc,unsigned lds_dst){unsigned keep;
  asm volatile("s_mov_b32 %0, m0\n\ts_mov_b32 m0, %2\n\ts_nop 0\n\tglobal_load_lds_dwordx4 %1, off\n\ts_mov_b32 m0, %0":"=&s"(keep):"v"(gsrc),"s"(lds_dst):"memory");}
__device__ __forceinline__ float max3f(float a,float b,float c){float r;asm("v_max3_f32 %0, %1, %2, %3":"=v"(r):"v"(a),"v"(b),"v"(c));return r;}
__device__ __forceinline__ float max2f(float a,float b){float r;asm("v_max_f32_e32 %0, %1, %2":"=v"(r):"v"(a),"v"(b));return r;}
__device__ __forceinline__ float fadd_s(float a,float b){float r;asm("v_add_f32_e32 %0, %1, %2":"=v"(r):"v"(a),"v"(b));return r;}
__device__ __forceinline__ float fsub_s(float a,float b){float r;asm("v_sub_f32_e32 %0, %1, %2":"=v"(r):"v"(a),"v"(b));return r;}
typedef float f32x2_t __attribute__((ext_vector_type(2))); typedef __bf16 bf16x2_t __attribute__((ext_vector_type(2)));
__device__ __forceinline__ unsigned cvtpk_s(float lo,float hi){f32x2_t v={lo,hi};bf16x2_t b=__builtin_convertvector(v,bf16x2_t);return __builtin_bit_cast(unsigned,b);}
#define WAIT_BAR(N) asm volatile("s_waitcnt vmcnt(" #N ") lgkmcnt(0)\n\ts_barrier":::"memory")

__device__ __forceinline__ void qkt(f32x16&p0,f32x16&p1,const char*Kslot,const bf16x8*qr,int r32,int hi){
  const char*kb=Kslot+hi*1024+r32*16;
  #pragma unroll
  for(int d0=0;d0<4;++d0){
    const bf16x8 b0=*reinterpret_cast<const bf16x8*>(kb+d0*2048);
    const bf16x8 b1=*reinterpret_cast<const bf16x8*>(kb+d0*2048+512);
    {p0=__builtin_amdgcn_mfma_f32_32x32x16_bf16(b0,qr[d0],p0,0,0,0);p1=__builtin_amdgcn_mfma_f32_32x32x16_bf16(b1,qr[d0],p1,0,0,0);}}
}
typedef __attribute__((address_space(3))) const char* lds_cptr;
typedef short v4i16_t __attribute__((ext_vector_type(4)));
__device__ __forceinline__ void kload8(bf16x8*kf,lds_cptr kp){
  kf[0]=*(const __attribute__((address_space(3))) bf16x8*)(kp);      kf[1]=*(const __attribute__((address_space(3))) bf16x8*)(kp+512);
  kf[2]=*(const __attribute__((address_space(3))) bf16x8*)(kp+2048); kf[3]=*(const __attribute__((address_space(3))) bf16x8*)(kp+2560);
  kf[4]=*(const __attribute__((address_space(3))) bf16x8*)(kp+4096); kf[5]=*(const __attribute__((address_space(3))) bf16x8*)(kp+4608);
  kf[6]=*(const __attribute__((address_space(3))) bf16x8*)(kp+6144); kf[7]=*(const __attribute__((address_space(3))) bf16x8*)(kp+6656);
}
__device__ __forceinline__ void kload2(bf16x8*kf,lds_cptr kp,int j){ kf[2*j]=*(const __attribute__((address_space(3))) bf16x8*)(kp+j*2048); kf[2*j+1]=*(const __attribute__((address_space(3))) bf16x8*)(kp+j*2048+512); }
__device__ __forceinline__ s16x4 vtr(lds_cptr p){ return __builtin_bit_cast(s16x4,__builtin_amdgcn_ds_read_tr16_b64_v4i16((__attribute__((address_space(3))) v4i16_t*)p)); }
__device__ __forceinline__ float rowmax(const f32x16&p0,const f32x16&p1){
  float a=max3f(p0[0],p0[1],p1[0]),b=max3f(p0[2],p0[3],p1[1]);a=max3f(a,p1[2],p1[3]);
  #pragma unroll
  for(int r=4;r<16;r+=4){a=max3f(a,p0[r],p0[r+1]);b=max3f(b,p0[r+2],p0[r+3]);a=max3f(a,p1[r],p1[r+1]);b=max3f(b,p1[r+2],p1[r+3]);}
  const float m=max2f(a,b);
  auto rr=__builtin_amdgcn_permlane32_swap(__float_as_uint(m),__float_as_uint(m),false,false);
  return max2f(__uint_as_float(rr[0]),__uint_as_float(rr[1]));
}
__device__ __forceinline__ void pv(f32x16*o,int vb,bf16x8 pa0,bf16x8 pa1,bf16x8 pa2,bf16x8 pa3){
  #pragma unroll
  for(int d0=0;d0<2;++d0){s16x4 lo[4],hi[4];
    #pragma unroll
    for(int ks=0;ks<4;++ks){
      asm volatile("ds_read_b64_tr_b16 %0,%1 offset:%c2":"=&v"(lo[ks]):"v"(vb),"i"(d0*4096+ks*1024):"memory");
      asm volatile("ds_read_b64_tr_b16 %0,%1 offset:%c2":"=&v"(hi[ks]):"v"(vb),"i"(d0*4096+ks*1024+512):"memory");}
    asm volatile("s_waitcnt lgkmcnt(0)":::"memory");SBAR();
    #define PK(k) (bf16x8){lo[k][0],lo[k][1],lo[k][2],lo[k][3],hi[k][0],hi[k][1],hi[k][2],hi[k][3]}
    o[d0]=__builtin_amdgcn_mfma_f32_32x32x16_bf16(pa0,PK(0),o[d0],0,0,0);
    o[d0]=__builtin_amdgcn_mfma_f32_32x32x16_bf16(pa1,PK(1),o[d0],0,0,0);
    o[d0]=__builtin_amdgcn_mfma_f32_32x32x16_bf16(pa2,PK(2),o[d0],0,0,0);
    o[d0]=__builtin_amdgcn_mfma_f32_32x32x16_bf16(pa3,PK(3),o[d0],0,0,0);
    #undef PK
  }
}

#ifndef ATTN_STORE16
#define ATTN_STORE16(p,v) (*(u32x4*)(p)=(v))
#endif
template<bool CAUSAL,int THRL> __device__ __forceinline__ void attn_unit(const bf16*Qw0,int qpitch,const bf16*__restrict__ Kh,const bf16*__restrict__ Vh,int kvpitch,bf16*Ow0,int opitch,int NT,const float*ckg,char*shm){
  const int tid=threadIdx.x; int lane_=tid&63; asm volatile("":"+v"(lane_)); const int lane=lane_,r32=lane&31,hi=lane>>5; const int wid=__builtin_amdgcn_readfirstlane(tid>>6);
  const bf16*Qw=Qw0+(long)(wid*QBLK)*qpitch;
  const unsigned lds0=(unsigned)(uintptr_t)shm;
  float*wsf=(float*)(shm+LDS_WS)+wid*64;
  const bf16*ksrc=Kh+(long)lane*kvpitch+wid*8;
  const bf16*vsrc=Vh+(long)(16*(wid&3)+(lane>>2))*kvpitch+(wid>>2)*32+(lane&3)*8;
  const unsigned kdst=lds0+LDS_K+wid*1024, vdst=lds0+LDS_V+wid*1024;
  #define DMA_K(t,slot) glds16(ksrc+(long)(t)*KVBLK*kvpitch,(unsigned)__builtin_amdgcn_readfirstlane(kdst+(slot)))
  #define DMA_V(t,slot) glds16(vsrc+(long)(t)*KVBLK*kvpitch,(unsigned)__builtin_amdgcn_readfirstlane(vdst+(slot)))
  const int vb0=(int)(lds0+LDS_V)+((lane>>4)&1)*32+(lane&3)*8+(4*hi+((lane&15)>>2))*64;
  const char*Kbase=shm+LDS_K; bf16x8 kf[8];
  const lds_cptr shm3=(lds_cptr)shm; const lds_cptr kp0=shm3+LDS_K+hi*1024+r32*16; const lds_cptr vp0=shm3+LDS_V+((lane>>4)&1)*32+(lane&3)*8+(4*hi+((lane&15)>>2))*64;
  DMA_K(0,0);DMA_V(0,0);DMA_K(1,SLOTB);
  bf16x8 qr[4];
  #pragma unroll
  for(int d0=0;d0<4;++d0)qr[d0]=*reinterpret_cast<const bf16x8*>(&Qw[(long)r32*qpitch+d0*16+hi*8]);
  typedef __attribute__((address_space(3))) float lds_f32; typedef __attribute__((address_space(3))) f32x4v lds_f32x4;
  lds_f32* const ckl=(lds_f32*)((lds_cptr)shm+LDS_CK);
  if(CAUSAL){ _Pragma("unroll") for(int i_=0;i_<2;++i_){ const int e4=(tid+512*i_)*4; if(e4<NT*KVBLK){ const f32x4v cv=*(const f32x4v*)(ckg+e4); *(lds_f32x4*)(ckl+e4)=cv; } } }
  float mhat=0.f,l_reg=0.f;f32x16 o[2];o[0]=f32x16{};o[1]=f32x16{};
  #define CINITH(C0,t,OFS) do{ const float nm_=-mhat; if(CAUSAL){ const lds_f32* cp_=ckl+(t)*KVBLK+4*hi+(OFS); \
      _Pragma("unroll") for(int g_=0;g_<4;++g_){ const f32x4v a_=*(const lds_f32x4*)(cp_+8*g_); \
        _Pragma("unroll") for(int j_=0;j_<4;++j_){ C0[4*g_+j_]=nm_-a_[j_]; } } } \
    else { _Pragma("unroll") for(int r_=0;r_<16;++r_){ C0[r_]=nm_; } } }while(0)
  #define CINIT(C0,C1,t) do{ CINITH(C0,t,0); CINITH(C1,t,32); }while(0)
  const int qrel=wid*QBLK+r32;
  #define CMASK(P0,P1,t) do{ if(CAUSAL){int jb_=(t)-(NT-4); if(jb_>=0)cmask(P0,P1,jb_,qrel,hi);} }while(0)
  bool resc=false;
  #define START(P0,P1) do{ const float rm=rowmax(P0,P1); resc=false; \
    { const float dl=rm; mhat=fadd_s(mhat,dl); \
      _Pragma("unroll") for(int r=0;r<16;++r){P0[r]=fsub_s(P0[r],dl);P1[r]=fsub_s(P1[r],dl);} } \
    _Pragma("unroll") for(int r=0;r<16;++r)P0[r]=__builtin_amdgcn_exp2f(P0[r]); }while(0)
  #define RESC() do{ if(resc){ asm volatile("s_waitcnt lgkmcnt(0)":::"memory"); \
      _Pragma("unroll") for(int d_=0;d_<2;++d_) _Pragma("unroll") for(int r=0;r<16;++r)o[d_][r]*=wsf[crow(r,hi)]; } }while(0)
  f32x16 pA0,pA1,pB0,pB1;
  int sl_prev=0,sl_cur=0,sl_next=SLOTB;
  #define ROT() do{sl_prev=sl_cur;sl_cur=sl_next;sl_next=(sl_next==(NSLOT-1)*SLOTB)?0:sl_next+SLOTB;}while(0)
  DMA_K(2,2*SLOTB);
  WAIT_BAR(3);
  CINIT(pA0,pA1,0); qkt(pA0,pA1,Kbase,qr,r32,hi);asm volatile("s_nop 15\n\ts_nop 7":"+v"(pA0),"+v"(pA1));CMASK(pA0,pA1,0);
  START(pA0,pA1);
  _Pragma("unroll") for(int r=0;r<16;++r)pA1[r]=__builtin_amdgcn_exp2f(pA1[r]);
  CINIT(pB0,pB1,1);
  WAIT_BAR(0);
  DMA_K(3,0);DMA_V(1,SLOTB);
  ROT();
  kload8(kf,kp0+sl_cur);
  WAIT_BAR(2);
  s16x4 vlo[8],vhi[8]; u32x4 pw0,pw1,pw2,pw3;
  #define PKW(P,B) cvtpk_s(P[B],P[B+1])
  #define PAF(k) __builtin_bit_cast(bf16x8,pw##k)
  #define VFR(i) (bf16x8){vlo[i][0],vlo[i][1],vlo[i][2],vlo[i][3],vhi[i][0],vhi[i][1],vhi[i][2],vhi[i][3]}
  #define PIN(x) asm volatile("":"+v"(x))
  #define MX3(a,b,c) __builtin_fmaxf(__builtin_fmaxf((a),(b)),(c))
  #define GAPA(MF,A0,A1,A2,A3,W0,W1,PW) do{ MF; sacc+=A0; sacc+=A1; sacc+=A2; sacc+=A3; PIN(sacc); W0; W1; PIN(PW); SBAR(); }while(0)
  #define EX(v) __builtin_amdgcn_exp2f(v)
  #define GAPB(MF,X,B) do{ MF; X[B]=EX(X[B]); X[B+1]=EX(X[B+1]); X[B+2]=EX(X[B+2]); X[B+3]=EX(X[B+3]); PIN(X); SBAR(); }while(0)
  #define VRD(i) do{ vlo[i]=vtr(vp_+(((i)>>2)*4096+((i)&3)*1024)); vhi[i]=vtr(vp_+(((i)>>2)*4096+((i)&3)*1024+512)); }while(0)
  #define KRD(G,j) do{ if(G){ kload2(kf,kp0+sl_next,j); SBAR(); } }while(0)
  #define STEP(C0,C1,P0,P1,t,GK,GV,GL) do{ SBAR(); \
    const lds_cptr vp_=vp0+sl_prev; \
    VRD(0); SBAR(); float sacc=(P0[0]+P0[1]); \
    GAPA(C0=__builtin_amdgcn_mfma_f32_32x32x16_bf16(kf[0],qr[0],C0,0,0,0), P0[2],P0[3],P0[4],P0[5],     pw0[0]=PKW(P0,0), pw0[1]=PKW(P0,2), pw0); \
    VRD(4); SBAR(); GAPA(C1=__builtin_amdgcn_mfma_f32_32x32x16_bf16(kf[1],qr[0],C1,0,0,0), P0[6],P0[7],P0[8],P0[9],     pw0[2]=PKW(P0,4), pw0[3]=PKW(P0,6), pw0); \
    VRD(1); SBAR(); GAPA(C0=__builtin_amdgcn_mfma_f32_32x32x16_bf16(kf[2],qr[1],C0,0,0,0),   P0[10],P0[11],P0[12],P0[13], pw1[0]=PKW(P0,8), pw1[1]=PKW(P0,10), pw1); \
    VRD(5); SBAR(); GAPA(C1=__builtin_amdgcn_mfma_f32_32x32x16_bf16(kf[3],qr[1],C1,0,0,0),   P0[14],P0[15],P1[0],P1[1],   pw1[2]=PKW(P0,12),pw1[3]=PKW(P0,14), pw1); \
    VRD(2); SBAR(); GAPA(C0=__builtin_amdgcn_mfma_f32_32x32x16_bf16(kf[4],qr[2],C0,0,0,0),   P1[2],P1[3],P1[4],P1[5],     pw2[0]=PKW(P1,0), pw2[1]=PKW(P1,2), pw2); \
    VRD(6); SBAR(); GAPA(C1=__builtin_amdgcn_mfma_f32_32x32x16_bf16(kf[5],qr[2],C1,0,0,0),   P1[6],P1[7],P1[8],P1[9],     pw2[2]=PKW(P1,4), pw2[3]=PKW(P1,6), pw2); \
    VRD(3); SBAR(); GAPA(C0=__builtin_amdgcn_mfma_f32_32x32x16_bf16(kf[6],qr[3],C0,0,0,0),   P1[10],P1[11],P1[12],P1[13], pw3[0]=PKW(P1,8), pw3[1]=PKW(P1,10), pw3); \
    VRD(7); SBAR(); GAPA(C1=__builtin_amdgcn_mfma_f32_32x32x16_bf16(kf[7],qr[3],C1,0,0,0),   P1[14],P1[15],0.f,0.f,       pw3[2]=PKW(P1,12),pw3[3]=PKW(P1,14), pw3); \
    l_reg+=sacc; \
    if(GK){DMA_K((t)+3,sl_cur);} if(GV){DMA_V((t)+1,sl_next);} \
    CMASK(C0,C1,t); \
    { float a=MX3(C0[0],C0[1],C1[0]),b=MX3(C0[2],C0[3],C1[1]); a=MX3(a,C1[2],C1[3]); \
      _Pragma("unroll") for(int r=4;r<16;r+=4){a=MX3(a,C0[r],C0[r+1]);b=MX3(b,C0[r+2],C0[r+3]);a=MX3(a,C1[r],C1[r+1]);b=MX3(b,C1[r+2],C1[r+3]);} \
      float rm=__builtin_fmaxf(a,b); { auto rr=__builtin_amdgcn_permlane32_swap(__float_as_uint(rm),__float_as_uint(rm),false,false); rm=__builtin_fmaxf(__uint_as_float(rr[0]),__uint_as_float(rr[1])); } \
      resc=false; \
      if(__builtin_expect(__any(rm>(float)THRL),0)){ const float dl=__builtin_fmaxf(rm,0.f); mhat+=dl; \
        _Pragma("unroll") for(int r=0;r<16;++r){C0[r]-=dl;C1[r]-=dl;} \
        const float f=__builtin_amdgcn_exp2f(-dl); l_reg*=f; if(hi==0)wsf[r32]=f; resc=true; } } \
    SBAR(); \
    GAPB(o[0]=__builtin_amdgcn_mfma_f32_32x32x16_bf16(PAF(0),VFR(0),o[0],0,0,0), C0,0); \
    GAPB(o[1]=__builtin_amdgcn_mfma_f32_32x32x16_bf16(PAF(0),VFR(4),o[1],0,0,0), C0,4); \
    if(GV){ CINITH(P0,(t)+1,0); SBAR(); } \
    KRD(GL,0); GAPB(o[0]=__builtin_amdgcn_mfma_f32_32x32x16_bf16(PAF(1),VFR(1),o[0],0,0,0), C0,8); \
    KRD(GL,1); GAPB(o[1]=__builtin_amdgcn_mfma_f32_32x32x16_bf16(PAF(1),VFR(5),o[1],0,0,0), C0,12); \
    KRD(GL,2); GAPB(o[0]=__builtin_amdgcn_mfma_f32_32x32x16_bf16(PAF(2),VFR(2),o[0],0,0,0), C1,0); \
    KRD(GL,3); GAPB(o[1]=__builtin_amdgcn_mfma_f32_32x32x16_bf16(PAF(2),VFR(6),o[1],0,0,0), C1,4); \
    if(GV){ CINITH(P1,(t)+1,32); SBAR(); } \
    GAPB(o[0]=__builtin_amdgcn_mfma_f32_32x32x16_bf16(PAF(3),VFR(3),o[0],0,0,0), C1,8); \
    GAPB(o[1]=__builtin_amdgcn_mfma_f32_32x32x16_bf16(PAF(3),VFR(7),o[1],0,0,0), C1,12); \
    }while(0)
  int t=1;
  #undef CMASK
  #define CMASK(P0,P1,t) do{}while(0)
  for(;t+5<NT;t+=2){
    STEP(pB0,pB1,pA0,pA1,t,true,true,true);     WAIT_BAR(2); RESC(); ROT();
    STEP(pA0,pA1,pB0,pB1,t+1,true,true,true);   WAIT_BAR(2); RESC(); ROT();
  }
  #undef CMASK
  #define CMASK(P0,P1,t) do{ if(CAUSAL){int jb_=(t)-(NT-4); if(jb_>=0)cmask(P0,P1,jb_,qrel,hi);} }while(0)
  #define ENDW(tt) do{ if((tt)+3<NT){WAIT_BAR(2);} else if((tt)+2<NT){WAIT_BAR(1);} else {WAIT_BAR(0);} }while(0)
  for(;t+1<NT;t+=2){
    STEP(pB0,pB1,pA0,pA1,t,(t+3<NT),(t+1<NT),(t+1<NT));       ENDW(t);   RESC(); ROT();
    STEP(pA0,pA1,pB0,pB1,t+1,(t+4<NT),(t+2<NT),(t+2<NT));     ENDW(t+1); RESC(); ROT();
  }
  STEP(pB0,pB1,pA0,pA1,NT-1,false,false,false); RESC();
  { float sacc=pB0[0]+pB0[1]; _Pragma("unroll") for(int r=2;r<16;++r)sacc+=pB0[r]; _Pragma("unroll") for(int r=0;r<16;++r)sacc+=pB1[r]; l_reg+=sacc;
    pw0=(u32x4){PKW(pB0,0),PKW(pB0,2),PKW(pB0,4),PKW(pB0,6)};pw1=(u32x4){PKW(pB0,8),PKW(pB0,10),PKW(pB0,12),PKW(pB0,14)};pw2=(u32x4){PKW(pB1,0),PKW(pB1,2),PKW(pB1,4),PKW(pB1,6)};pw3=(u32x4){PKW(pB1,8),PKW(pB1,10),PKW(pB1,12),PKW(pB1,14)};
    SBAR(); pv(o,vb0+sl_cur,PAF(0),PAF(1),PAF(2),PAF(3)); }
  #undef PKW
  #undef PAF
  #undef VFR
  #undef PIN
  #undef MX3
  #undef GAPA
  #undef GAPB
  #undef EX
  #undef VRD
  #undef KRD
  #undef STEP
  #undef ENDW
  {auto rr=__builtin_amdgcn_permlane32_swap(__float_as_uint(l_reg),__float_as_uint(l_reg),false,false);l_reg=__uint_as_float(rr[0])+__uint_as_float(rr[1]);}
  if(hi==0)wsf[32+r32]=l_reg;asm volatile("s_waitcnt lgkmcnt(0)":::"memory");
  float rli[16];
  #pragma unroll
  for(int r=0;r<16;++r)rli[r]=__builtin_amdgcn_rcpf(wsf[32+crow(r,hi)]);
  bf16*Ow=Ow0+(long)(wid*QBLK)*opitch;
  { bf16*stg=(bf16*)(shm+LDS_OST)+wid*2048;
    #pragma unroll
    for(int r=0;r<16;++r){const int orow=crow(r,hi);
      #pragma unroll
      for(int d0=0;d0<2;++d0)stg[orow*64+d0*32+r32]=__float2bfloat16(o[d0][r]*rli[r]);}
    asm volatile("s_waitcnt lgkmcnt(0)":::"memory");
    #pragma unroll
    for(int i=0;i<4;++i){const int row=i*8+(lane>>3),ch=lane&7; const u32x4 v=*(const u32x4*)(stg+row*64+ch*8); ATTN_STORE16(Ow+(long)row*opitch+ch*8,v);} }
  asm volatile("s_waitcnt lgkmcnt(0)\n\ts_barrier":::"memory");
  #undef CINIT
  #undef CINITH
  #undef DMA_K
  #undef DMA_V
  #undef CMASK
  #undef START
  #undef RESC
  #undef ROT
}
constexpr int ATTN_LDS_BYTES=LDS_BYTES;
#undef SBAR
#undef WAIT_BAR
}
#include <hip/hip_cooperative_groups.h>
namespace cg = cooperative_groups;

#define GAS __attribute__((address_space(1)))
#define LAS __attribute__((address_space(3)))
typedef unsigned short bf16;
typedef unsigned v4u __attribute__((ext_vector_type(4)));
typedef unsigned v2u __attribute__((ext_vector_type(2)));
typedef float f32x4 __attribute__((ext_vector_type(4)));
typedef float f32x16 __attribute__((ext_vector_type(16)));
typedef short bf16x8 __attribute__((ext_vector_type(8)));

constexpr int NWAVES = 8;
constexpr int BATCH = 8, SEQ = 4096, DM = 1024, M = BATCH * SEQ;
constexpr int NMEM = 256, MROWS = BATCH * NMEM;
constexpr int MIXW = 768, MEMW = 256, DFF = 2816, NH = 12, HD = 64;
constexpr int N_LRU = 2 * MIXW + MEMW;
constexpr int N_FOX_SRC = 3 * MIXW + NH + MEMW;
constexpr int N_FOX_GEMM = 2560;
constexpr int N_FOX = 2816;
constexpr float C2 = 0.125f * 1.4426950408889634f;
constexpr float LOG2E = 1.4426950408889634f;

constexpr size_t MiB = 1u << 20;
constexpr size_t WS_WRG = 1 * MiB, WS_WIG = 1 * MiB + 128 * 1024;
constexpr size_t WS_WKV = 2 * MiB, WS_WOUT0 = 3 * MiB, WS_WOUT1 = 5 * MiB, WS_WLRU = 7 * MiB, WS_WFOX = 11 * MiB;
constexpr size_t WS_W1 = 17 * MiB, W1_BYTES = 11 * MiB;
constexpr size_t WS_W2 = 61 * MiB, W2_BYTES = 5 * MiB + 512 * 1024;
constexpr size_t WS_MEMB = 83 * MiB, WS_MEMKV = 87 * MiB;
constexpr size_t WS_SSQ = 89 * MiB, WS_SSQM = 91 * MiB;
constexpr size_t WS_LOGF = 92 * MiB, WS_CK = 94 * MiB, WS_SUMM = 96 * MiB;
constexpr size_t WS_HB = 98 * MiB, WS_CAT = 162 * MiB, WS_R = 226 * MiB, WS_END = 402 * MiB;
constexpr size_t R_AL = (size_t)M * N_LRU * 2;
static_assert(R_AL + (size_t)M * MIXW * 2 <= 176 * MiB, "R region");

constexpr int RING_BYTES = 131072, LDS_BYTES = 147456, XS_OFF = RING_BYTES, MISC_OFF = RING_BYTES + 8192;
static_assert(attn_body::ATTN_LDS_BYTES <= RING_BYTES, "attention LDS");

__device__ __forceinline__ unsigned f2bf(float f) { unsigned u = __builtin_bit_cast(unsigned, f); return (u + 0x7fffu + ((u >> 16) & 1u)) >> 16; }
__device__ __forceinline__ unsigned pk2(float lo, float hi) { return f2bf(lo) | (f2bf(hi) << 16); }
__device__ __forceinline__ float bf_lo(unsigned w) { return __builtin_bit_cast(float, w << 16); }
__device__ __forceinline__ float bf_hi(unsigned w) { return __builtin_bit_cast(float, w & 0xffff0000u); }
__device__ __forceinline__ float wave_sum(float v) {
#pragma unroll
    for (int o = 1; o < 64; o <<= 1) v += __shfl_xor(v, o);
    return v;
}

typedef GAS unsigned gu32;
#define RLX_AGENT __ATOMIC_RELAXED, __HIP_MEMORY_SCOPE_AGENT
#define XB_TMO      128
#define XB_XCNT(j)  (256  + 64 * (j))
#define XB_XSUB(j)  (1280 + 64 * (j))
#define XB_XGEN(j)  (2304 + 64 * (j))
#define XB_TOP      3328
#define XB_TOPGEN   3392
#define XCD_BAR_WORDS 3456
#define XB_SPIN_CAP (1u << 18)

__device__ __forceinline__ unsigned xb_ld(unsigned* p)              { return __hip_atomic_load(p, __ATOMIC_RELAXED, __HIP_MEMORY_SCOPE_AGENT); }
__device__ __forceinline__ unsigned xb_add(unsigned* p, unsigned v) { return __hip_atomic_fetch_add(p, v, __ATOMIC_RELAXED, __HIP_MEMORY_SCOPE_AGENT); }
__device__ __forceinline__ unsigned xb_xcc_id() { return (unsigned)__builtin_amdgcn_s_getreg((3 << 11) | 20) & 0xFu; }
#define XB_SPIN(cond, bar) do { unsigned _sp = 0; while (cond) { __builtin_amdgcn_s_sleep(1); \
    if ((++_sp & 255u) == 0u) { if (xb_ld(&(bar)[XB_TMO])) break; if (_sp > XB_SPIN_CAP) { atomicAdd(&(bar)[XB_TMO], 1u); break; } } } } while (0)

struct XcdBarrier {
    unsigned* bar; unsigned x;
    volatile LAS unsigned* st;
};

__device__ __forceinline__ XcdBarrier xcd_barrier_post(unsigned* bar, volatile LAS unsigned* st) {
    XcdBarrier b; b.bar = bar; b.x = xb_xcc_id(); b.st = st;
    if (threadIdx.x == 0) (void)xb_add(&bar[XB_XCNT(b.x)], 1u);
    return b;
}
__device__ __forceinline__ void xcd_barrier_complete(unsigned* bar, unsigned x, unsigned& nloc, unsigned& nx) {
    const unsigned G = gridDim.x * gridDim.y * gridDim.z;
    unsigned sum, cnt, mine, sp = 0u;
    for (;;) {
        sum = 0u; cnt = 0u; mine = 0u;
#pragma unroll
        for (unsigned j = 0; j < 16; ++j) { const unsigned c = xb_ld(&bar[XB_XCNT(j)]); sum += c; cnt += (c > 0u) ? 1u : 0u; mine = (j == x) ? c : mine; }
        if (sum == G) break;
        __builtin_amdgcn_s_sleep(1);
        if ((++sp & 255u) == 0u) { if (xb_ld(&bar[XB_TMO])) break; if (sp > XB_SPIN_CAP) { atomicAdd(&bar[XB_TMO], 1u); break; } }
    }
    nloc = mine > 0u ? mine : 1u; nx = cnt > 0u ? cnt : 1u;
}

__device__ __forceinline__ void xcd_barrier(const XcdBarrier& b) {
    asm volatile("s_waitcnt vmcnt(0)" ::: "memory");
    __syncthreads();
    if (threadIdx.x == 0) {
        unsigned* bar = b.bar;
        __builtin_amdgcn_s_waitcnt(0);
        unsigned nloc = b.st[0], nx = b.st[1];
        if (nloc == 0u) { xcd_barrier_complete(bar, b.x, nloc, nx); b.st[0] = nloc; b.st[1] = nx; }
        const unsigned old = xb_add(&bar[XB_XSUB(b.x)], 1u);
        const unsigned gen = old / nloc;
        if (old + 1u == (gen + 1u) * nloc) {
            __builtin_amdgcn_fence(__ATOMIC_RELEASE, "agent");
            asm volatile("s_waitcnt vmcnt(0)" ::: "memory");
            const unsigned og = xb_add(&bar[XB_TOP], 1u);
            const unsigned tg = og / nx;
            if (og + 1u == (tg + 1u) * nx) xb_add(&bar[XB_TOPGEN], 1u);
            else XB_SPIN(xb_ld(&bar[XB_TOPGEN]) == tg, bar);
            __builtin_amdgcn_fence(__ATOMIC_ACQUIRE, "agent");
            xb_add(&bar[XB_XGEN(b.x)], 1u);
            asm volatile("s_waitcnt vmcnt(0)" ::: "memory");
        } else {
            XB_SPIN(xb_ld(&bar[XB_XGEN(b.x)]) == gen, bar);
            __builtin_amdgcn_fence(__ATOMIC_ACQUIRE, "agent");
            asm volatile("s_waitcnt vmcnt(0)" ::: "memory");
        }
    }
    __syncthreads();
}

__device__ __forceinline__ void transpose_item(const float* W, int K, int Nsrc, const float* g, bf16* Bt, int n0, int src0, int nvalid, int k0, LAS float* scr, int lane) {
    { const int n = lane & 31, kh = lane >> 5; const bool ok = n < nvalid; const float* wp = W + (size_t)(k0 + kh) * Nsrc + src0 + n; float v[32];
#pragma unroll
      for (int i = 0; i < 32; ++i) v[i] = ok ? wp[(size_t)(2 * i) * Nsrc] : 0.f;
      if (g) {
#pragma unroll
        for (int i = 0; i < 32; ++i) v[i] *= g[k0 + 2 * i + kh]; }
#pragma unroll
      for (int i = 0; i < 32; ++i) scr[(2 * i + kh) * 33 + n] = v[i]; }
    asm volatile("s_waitcnt lgkmcnt(0)" ::: "memory");
    const int c = lane & 7;
#pragma unroll
    for (int j = 0; j < 4; ++j) { const int n = (lane >> 3) + 8 * j; const LAS float* s = scr + (8 * c) * 33 + n;
        v4u o; o.x = pk2(s[0 * 33], s[1 * 33]); o.y = pk2(s[2 * 33], s[3 * 33]); o.z = pk2(s[4 * 33], s[5 * 33]); o.w = pk2(s[6 * 33], s[7 * 33]);
        *(v4u*)(Bt + (size_t)(n0 + n) * K + k0 + 8 * c) = o; }
    asm volatile("s_waitcnt lgkmcnt(0)" ::: "memory");
}
__device__ __forceinline__ void granule_map(int mode, int gr, int& src0, int& nvalid) {
    const int n0 = gr * 32; nvalid = 32;
    if (mode == 0) { src0 = n0; return; }
    const int tile = n0 >> 8, L = n0 & 255;
    if (mode == 1) { src0 = (L < 128) ? (128 * tile + L) : (DFF + 128 * tile + (L - 128)); return; }
    const int a = 64 * ((L >> 5) & 3) + 32 * (L >> 7);
    const int lc = 256 * tile + a;
    if (mode == 2) { src0 = lc; return; }
    if (lc < 3 * MIXW) { src0 = lc; return; }
    if (lc < 3 * MIXW + MEMW) { src0 = lc + NH; return; }
    if (lc == 3 * MIXW + MEMW) { src0 = 3 * MIXW; nvalid = NH; return; }
    src0 = 0; nvalid = 0;
}
__device__ __forceinline__ void convert_weight(const float* W, int K, int Nsrc, int Ndst, const float* g, bf16* Bt, int mode, LAS float* scr, int lane, int gw, int NGW) {
    const int nk = K / 64, ngr = Ndst / 32, items = nk * ngr;
    for (int it = gw; it < items; it += NGW) { const int gr = it % ngr, kb = it / ngr; int src0, nvalid; granule_map(mode, gr, src0, nvalid);
        transpose_item(W, K, Nsrc, g, Bt, gr * 32, src0, nvalid, kb * 64, scr, lane); }
}
__device__ __forceinline__ void row_to_bf16_ssq(const float* xrow, bf16* orow, float* ssqrow, int lane) {
    const f32x4* xr = (const f32x4*)xrow + lane; f32x4 v[4]; float s = 0.f;
#pragma unroll
    for (int j = 0; j < 4; ++j) { v[j] = xr[64 * j]; s += (v[j][0] * v[j][0] + v[j][1] * v[j][1]) + (v[j][2] * v[j][2] + v[j][3] * v[j][3]); }
    s = wave_sum(s);
    v2u* o8 = (v2u*)orow + lane;
#pragma unroll
    for (int j = 0; j < 4; ++j) { v2u w; w.x = pk2(v[j][0], v[j][1]); w.y = pk2(v[j][2], v[j][3]); o8[64 * j] = w; }
    if (lane < 4) ssqrow[lane] = (lane == 0) ? s : 0.f;
}

namespace lru {
constexpr int XCS = 68;
constexpr int XC_BYTES = 32 * XCS * 4;
constexpr int OFF_WS = NWAVES * XC_BYTES;
constexpr int OFF_CARRY = OFF_WS + NWAVES * 64 * 2 * 4;
__device__ __forceinline__ int crow(int r, int hi) { return (r & 3) + 8 * (r >> 2) + 4 * hi; }
__device__ __forceinline__ float sigm(float x) { return __builtin_amdgcn_rcpf(1.0f + __builtin_amdgcn_exp2f(-x * LOG2E)); }

__device__ __forceinline__ void unit_a(int b, int h, int c, const bf16* P, const float* conv_w, const float* conv_b, const bf16* WrgT, const bf16* WigT,
                                       const float* b_rg, const float* b_ig, const float* lam, bf16* cat, bf16* AL, float* summ, LAS unsigned char* lds) {
    int tid_ = threadIdx.x; asm volatile("" : "+v"(tid_)); const int tid = tid_, lane = tid & 63, r32 = lane & 31, hi = lane >> 5; const int w = __builtin_amdgcn_readfirstlane(tid >> 6);
    const int t0 = c * 256 + w * 32; const long row0 = (long)b * SEQ + t0;
    LAS float* xc = (LAS float*)(lds + w * XC_BYTES);
    bf16x8 afr[4];
#pragma unroll
    for (int kk = 0; kk < 4; ++kk) {
        const int ch0 = 16 * kk + 8 * hi, gch = h * HD + ch0;
        f32x4 a0 = *(const f32x4*)(conv_b + gch), a1 = *(const f32x4*)(conv_b + gch + 4);
#pragma unroll
        for (int tap = 0; tap < 4; ++tap) {
            const int tt = t0 + r32 - 3 + tap;
            if (tt >= 0) {
                const v4u xv = *(const v4u*)(P + (size_t)(row0 + r32 - 3 + tap) * N_LRU + gch);
                const f32x4 w0 = *(const f32x4*)(conv_w + tap * MIXW + gch), w1 = *(const f32x4*)(conv_w + tap * MIXW + gch + 4);
                a0[0] += w0[0] * bf_lo(xv.x); a0[1] += w0[1] * bf_hi(xv.x); a0[2] += w0[2] * bf_lo(xv.y); a0[3] += w0[3] * bf_hi(xv.y);
                a1[0] += w1[0] * bf_lo(xv.z); a1[1] += w1[1] * bf_hi(xv.z); a1[2] += w1[2] * bf_lo(xv.w); a1[3] += w1[3] * bf_hi(xv.w);
            }
        }
        *(LAS f32x4*)(xc + r32 * XCS + ch0) = a0; *(LAS f32x4*)(xc + r32 * XCS + ch0 + 4) = a1;
        v4u pk; pk.x = pk2(a0[0], a0[1]); pk.y = pk2(a0[2], a0[3]); pk.z = pk2(a1[0], a1[1]); pk.w = pk2(a1[2], a1[3]);
        afr[kk] = __builtin_bit_cast(bf16x8, pk);
    }
    f32x16 acc[2][2];
#pragma unroll
    for (int g = 0; g < 2; ++g)
#pragma unroll
        for (int jt = 0; jt < 2; ++jt) { f32x16 z = {}; const bf16* WT = (g == 0 ? WrgT : WigT) + (size_t)((h * HD + 32 * jt + r32) * HD + 8 * hi);
#pragma unroll
            for (int kk = 0; kk < 4; ++kk) { const bf16x8 bfr = *(const bf16x8*)(WT + 16 * kk); z = __builtin_amdgcn_mfma_f32_32x32x16_bf16(afr[kk], bfr, z, 0, 0, 0); }
            acc[g][jt] = z; }
    asm volatile("s_waitcnt lgkmcnt(0)" ::: "memory"); __builtin_amdgcn_wave_barrier();
#pragma unroll
    for (int jt = 0; jt < 2; ++jt) {
        const int gch = h * HD + 32 * jt + r32;
        const float brg = b_rg[gch], big = b_ig[gch], sp = log1pf(expf(-lam[gch]));
#pragma unroll
        for (int r = 0; r < 16; ++r) {
            const float xcv = xc[crow(r, hi) * XCS + 32 * jt + r32];
            const float rg = sigm(acc[0][jt][r] + brg), ig = sigm(acc[1][jt][r] + big);
            const float la = -8.0f * rg * sp, a = __builtin_amdgcn_exp2f(la * LOG2E);
            const float x2 = 2.0f * la;
            const float em = (x2 > -0.25f) ? x2 * (1.0f + x2 * 0.5f * (1.0f + x2 * (1.0f / 3.0f) * (1.0f + x2 * 0.25f * (1.0f + x2 * 0.2f)))) : (a * a - 1.0f);
            acc[0][jt][r] = a; acc[1][jt][r] = __builtin_sqrtf(fmaxf(-em, 0.f)) * ig * xcv;
        }
    }
    asm volatile("s_waitcnt lgkmcnt(0)" ::: "memory"); __builtin_amdgcn_wave_barrier();
    LAS float* wsA = (LAS float*)(lds + OFF_WS);
#pragma unroll
    for (int jt = 0; jt < 2; ++jt) {
        float AG[4], HG[4];
#pragma unroll
        for (int q = 0; q < 4; ++q) { float A = 1.f, H = 0.f;
#pragma unroll
            for (int i = 0; i < 4; ++i) { const int r = 4 * q + i; const float a = acc[0][jt][r], bx = acc[1][jt][r]; H = a * H + bx; A = A * a; acc[1][jt][r] = H; acc[0][jt][r] = A; }
            AG[q] = A; HG[q] = H; }
        float Ac = 1.f, Hc = 0.f, cinA[4], cinH[4];
#pragma unroll
        for (int q = 0; q < 4; ++q) {
            const float pA = __shfl_xor(AG[q], 32), pH = __shfl_xor(HG[q], 32);
            const float fA = hi ? pA : AG[q], fH = hi ? pH : HG[q], sA = hi ? AG[q] : pA, sH = hi ? HG[q] : pH;
            const float A0 = Ac, H0 = Hc;
            Hc = fA * Hc + fH; Ac = Ac * fA;
            cinA[q] = hi ? Ac : A0; cinH[q] = hi ? Hc : H0;
            Hc = sA * Hc + sH; Ac = Ac * sA;
        }
#pragma unroll
        for (int r = 0; r < 16; ++r) { const int q = r >> 2; acc[1][jt][r] += acc[0][jt][r] * cinH[q]; acc[0][jt][r] *= cinA[q]; }
        if (hi == 0) { wsA[(w * 64 + 32 * jt + r32) * 2 + 0] = Ac; wsA[(w * 64 + 32 * jt + r32) * 2 + 1] = Hc; }
    }
    __syncthreads();
#pragma unroll
    for (int jt = 0; jt < 2; ++jt) {
        const int ch = 32 * jt + r32; float Ain = 1.f, Hin = 0.f, At = 1.f, Ht = 0.f;
#pragma unroll
        for (int w2 = 0; w2 < NWAVES; ++w2) { const float A = wsA[(w2 * 64 + ch) * 2 + 0], H = wsA[(w2 * 64 + ch) * 2 + 1];
            if (w2 == w) { Ain = At; Hin = Ht; }
            Ht = A * Ht + H; At = At * A; }
        if (w == NWAVES - 1 && hi == 0) { float* sp = summ + (size_t)(((b * NH + h) * 16 + c) * 2) * 64; sp[ch] = At; sp[64 + ch] = Ht; }
#pragma unroll
        for (int r = 0; r < 16; ++r) { acc[1][jt][r] += acc[0][jt][r] * Hin; acc[0][jt][r] *= Ain; }
    }
    LAS bf16* stg = (LAS bf16*)xc;
#pragma unroll
    for (int jt = 0; jt < 2; ++jt)
#pragma unroll
        for (int r = 0; r < 16; ++r) { const int tt = crow(r, hi), ch = 32 * jt + r32; stg[tt * 64 + ch] = (bf16)f2bf(acc[1][jt][r]); stg[2048 + tt * 64 + ch] = (bf16)f2bf(acc[0][jt][r]); }
    asm volatile("s_waitcnt lgkmcnt(0)" ::: "memory"); __builtin_amdgcn_wave_barrier();
#pragma unroll
    for (int i = 0; i < 4; ++i) { const int row = i * 8 + (lane >> 3), chk = lane & 7;
        const v4u hv = *(const LAS v4u*)(stg + row * 64 + chk * 8), av = *(const LAS v4u*)(stg + 2048 + row * 64 + chk * 8);
        *(v4u*)(cat + (size_t)(row0 + row) * DM + h * HD + chk * 8) = hv;
        *(v4u*)(AL + (size_t)(row0 + row) * MIXW + h * HD + chk * 8) = av; }
    __syncthreads();
}
__device__ __forceinline__ void unit_b(int b, int h, int c, const bf16* P, const bf16* AL, const float* summ, bf16* cat, LAS unsigned char* lds) {
    int tid_ = threadIdx.x; asm volatile("" : "+v"(tid_)); const int tid = tid_; LAS float* carry = (LAS float*)(lds + OFF_CARRY);
    if (tid < 64) { float Hc = 0.f; const float* sp = summ + (size_t)((b * NH + h) * 16) * 2 * 64;
        for (int c2 = 0; c2 < c; ++c2) { const float A = sp[c2 * 128 + tid], H = sp[c2 * 128 + 64 + tid]; Hc = A * Hc + H; }
        carry[tid] = Hc; }
    __syncthreads();
    const long R0 = (long)b * SEQ + c * 256;
#pragma unroll
    for (int i = 0; i < 4; ++i) { const int idx = tid + 512 * i, row = idx >> 3, chk = idx & 7;
        bf16* cp = cat + (size_t)(R0 + row) * DM + h * HD + chk * 8;
        const v4u hv = *(const v4u*)cp, av = *(const v4u*)(AL + (size_t)(R0 + row) * MIXW + h * HD + chk * 8), gv = *(const v4u*)(P + (size_t)(R0 + row) * N_LRU + MIXW + h * HD + chk * 8);
        const f32x4 c0 = *(const LAS f32x4*)(carry + chk * 8), c1 = *(const LAS f32x4*)(carry + chk * 8 + 4);
        float o[8];
#define LRU_B1(k, hw, aw, gw_, cc) { const float hh = hw + aw * cc; const float gg = gw_; const float u2 = 1.5957691216f * (gg + 0.044715f * gg * gg * gg); o[k] = hh * gg * sigm(u2); }
        LRU_B1(0, bf_lo(hv.x), bf_lo(av.x), bf_lo(gv.x), c0[0]) LRU_B1(1, bf_hi(hv.x), bf_hi(av.x), bf_hi(gv.x), c0[1])
        LRU_B1(2, bf_lo(hv.y), bf_lo(av.y), bf_lo(gv.y), c0[2]) LRU_B1(3, bf_hi(hv.y), bf_hi(av.y), bf_hi(gv.y), c0[3])
        LRU_B1(4, bf_lo(hv.z), bf_lo(av.z), bf_lo(gv.z), c1[0]) LRU_B1(5, bf_hi(hv.z), bf_hi(av.z), bf_hi(gv.z), c1[1])
        LRU_B1(6, bf_lo(hv.w), bf_lo(av.w), bf_lo(gv.w), c1[2]) LRU_B1(7, bf_hi(hv.w), bf_hi(av.w), bf_hi(gv.w), c1[3])
#undef LRU_B1
        v4u ov; ov.x = pk2(o[0], o[1]); ov.y = pk2(o[2], o[3]); ov.z = pk2(o[4], o[5]); ov.w = pk2(o[6], o[7]);
        *(v4u*)cp = ov; }
    __syncthreads();
}
}

__device__ __forceinline__ void fgate_unit(int u, const bf16* hb, const bf16* Wf, const float* ssq, const float* bf, float* logf) {
    int tid_ = threadIdx.x; asm volatile("" : "+v"(tid_)); const int lane = tid_ & 63, r32 = lane & 31, hi = lane >> 5; const int w = __builtin_amdgcn_readfirstlane(tid_ >> 6);
    if (w >= 4) return;
    const int row0 = u * 128 + w * 32;
    const bf16* ap = hb + (size_t)(row0 + r32) * DM + 8 * hi; const bf16* bp = Wf + (size_t)r32 * DM + 8 * hi;
    f32x16 acc = {};
#pragma unroll 8
    for (int kk = 0; kk < 64; ++kk) { const bf16x8 a = *(const bf16x8*)(ap + 16 * kk), b = *(const bf16x8*)(bp + 16 * kk); acc = __builtin_amdgcn_mfma_f32_32x32x16_bf16(a, b, acc, 0, 0, 0); }
    if (r32 < NH) { const float bfe = bf[r32];
#pragma unroll
        for (int r = 0; r < 16; ++r) { const int row = row0 + (r & 3) + 8 * (r >> 2) + 4 * hi; const f32x4 p = *(const f32x4*)(ssq + (size_t)row * 4);
            const float rs = __builtin_amdgcn_rsqf(((p[0] + p[1]) + (p[2] + p[3])) * (1.0f / 1024.0f) + 1e-6f);
            const float x = acc[r] * rs + bfe; const float ls = fminf(x, 0.f) - log1pf(__expf(-fabsf(x)));
            logf[(size_t)((row >> 12) * NH + r32) * SEQ + (row & 4095)] = ls; } }
}

__device__ __forceinline__ void cumsum_unit(const float* logf, float* ck2, int s, LAS unsigned char* lds) {
    int tid_ = threadIdx.x; asm volatile("" : "+v"(tid_)); const int tid = tid_, lane = tid & 63, w = tid >> 6; LAS float* wt = (LAS float*)lds;
    const f32x4* src = (const f32x4*)(logf + (size_t)s * SEQ) + tid * 2; f32x4 a = src[0], b = src[1];
    a[1] += a[0]; a[2] += a[1]; a[3] += a[2]; b[0] += a[3]; b[1] += b[0]; b[2] += b[1]; b[3] += b[2];
    float tot = b[3], inc = tot;
#pragma unroll
    for (int o = 1; o < 64; o <<= 1) { const float t = __shfl_up(inc, o); if (lane >= o) inc += t; }
    if (lane == 63) wt[w] = inc;
    __syncthreads();
    float off = inc - tot;
    for (int w2 = 0; w2 < w; ++w2) off += wt[w2];
    f32x4* dst = (f32x4*)(ck2 + (size_t)s * SEQ) + tid * 2;
    dst[0] = (a + off) * LOG2E; dst[1] = (b + off) * LOG2E;
    __syncthreads();
}

__device__ __forceinline__ const float* inp(int i) { unsigned off = (unsigned)i * 8u; asm volatile("" : "+s"(off));
    return *(const float* const __attribute__((address_space(4)))*)((const __attribute__((address_space(4))) char*)__builtin_amdgcn_kernarg_segment_ptr() + off); }
#define IN_x inp(0)
#define IN_mem inp(1)
#define IN_mem_norm_g inp(2)
#define IN_mem_w_kv inp(3)
#define IN_mem_k_norm_g inp(4)
#define IN_ffn1_norm_g inp(5)
#define IN_ffn1_w_in inp(6)
#define IN_ffn1_w_out inp(7)
#define IN_mix_norm_g inp(8)
#define IN_mix_w_out inp(9)
#define IN_memq_norm_g inp(10)
#define IN_ffn2_norm_g inp(11)
#define IN_ffn2_w_in inp(12)
#define IN_ffn2_w_out inp(13)
#define IN_lru_w_in inp(14)
#define IN_lru_conv_w inp(15)
#define IN_lru_conv_b inp(16)
#define IN_lru_w_rg inp(17)
#define IN_lru_b_rg inp(18)
#define IN_lru_w_ig inp(19)
#define IN_lru_b_ig inp(20)
#define IN_lru_lambda inp(21)
#define IN_fox_w_in inp(22)
#define IN_fox_b_f inp(23)
#define IN_fox_q_norm_g inp(24)
#define IN_fox_k_norm_g inp(25)
#ifndef PROBE_DUP_G1
#define PROBE_DUP_G1 0
#endif
#ifndef PROBE_SYNCS
#define PROBE_SYNCS 0
#endif
#ifndef PROBE_DUP_PRO
#define PROBE_DUP_PRO 0
#endif
#ifndef PROBE_DUP_MIX0
#define PROBE_DUP_MIX0 0
#endif
#ifndef PROBE_DUP_MIX
#define PROBE_DUP_MIX 0
#endif
struct Args { const float* in[26]; float* out; unsigned char* ws; };
#define PHASE_BEGIN int bxl = blockIdx.x, Gl = gridDim.x; asm volatile("" : "+s"(bxl), "+s"(Gl)); const int vcul = (Gl % 8 == 0) ? (bxl % 8) * (Gl / 8) + bxl / 8 : bxl; unsigned char* const wsl = (unsigned char*)inp(27); (void)vcul; (void)wsl
#define WSP(T, off) ((T*)(wsl + (off)))
__global__ void __launch_bounds__(NWAVES * 64, 2) mega_fwd(Args args) {
    extern __shared__ __attribute__((aligned(16))) unsigned char lds[];
    cg::grid_group grid = cg::this_grid();
    LAS unsigned char* L = (LAS unsigned char*)lds;
    {
        const int tid = threadIdx.x;
        if (tid < 2) ((volatile LAS unsigned*)(L + MISC_OFF))[tid] = 0u;
        __syncthreads();
    }
    const XcdBarrier bar = xcd_barrier_post((unsigned*)inp(27), (volatile LAS unsigned*)(L + MISC_OFF));
    for (int rep_ = 0; rep_ < 1 + PROBE_DUP_PRO; ++rep_) {
        PHASE_BEGIN; int tid_ = threadIdx.x; asm volatile("" : "+v"(tid_)); const int lane = tid_ & 63, wave = __builtin_amdgcn_readfirstlane(tid_ >> 6);
        LAS float* scr = (LAS float*)(L + wave * 16384);
        const int gw = vcul * NWAVES + wave, NGW = Gl * NWAVES;
#pragma unroll 1
        for (int s = 0; s < 4; ++s) { const int l = s >> 1, f = s & 1;
            const float* win = (f ? IN_ffn2_w_in : IN_ffn1_w_in) + (size_t)l * DM * 2 * DFF; const float* wout = (f ? IN_ffn2_w_out : IN_ffn1_w_out) + (size_t)l * DFF * DM; const float* g = (f ? IN_ffn2_norm_g : IN_ffn1_norm_g) + l * DM;
            convert_weight(win, DM, 2 * DFF, 2 * DFF, g, (bf16*)(wsl + WS_W1 + s * W1_BYTES), 1, scr, lane, gw, NGW);
            convert_weight(wout, DFF, DM, DM, nullptr, (bf16*)(wsl + WS_W2 + s * W2_BYTES), 0, scr, lane, gw, NGW); }
        convert_weight(IN_lru_w_in, DM, N_LRU, N_LRU, IN_mix_norm_g, WSP(bf16, WS_WLRU), 2, scr, lane, gw, NGW);
        convert_weight(IN_fox_w_in, DM, N_FOX_SRC, N_FOX, IN_mix_norm_g + DM, WSP(bf16, WS_WFOX), 3, scr, lane, gw, NGW);
        convert_weight(IN_mix_w_out, DM, DM, DM, nullptr, WSP(bf16, WS_WOUT0), 0, scr, lane, gw, NGW);
        convert_weight(IN_mix_w_out + (size_t)DM * DM, DM, DM, DM, nullptr, WSP(bf16, WS_WOUT1), 0, scr, lane, gw, NGW);
        convert_weight(IN_mem_w_kv, DM, 2 * MEMW, 2 * MEMW, IN_mem_norm_g, WSP(bf16, WS_WKV), 2, scr, lane, gw, NGW);
        { const float* wrg = IN_lru_w_rg; const float* wig = IN_lru_w_ig; bf16* WrgT = WSP(bf16, WS_WRG); bf16* WigT = WSP(bf16, WS_WIG);
          for (int e = gw * 64 + lane; e < NH * HD * HD; e += NGW * 64) { const int hh = e / (HD * HD), j = (e / HD) % HD, i = e % HD;
            WrgT[e] = (bf16)f2bf(wrg[(hh * HD + i) * HD + j]); WigT[e] = (bf16)f2bf(wig[(hh * HD + i) * HD + j]); } }
        { const float* x = IN_x; bf16* hb = WSP(bf16, WS_HB); float* ssq = WSP(float, WS_SSQ);
          for (int m = gw; m < M; m += NGW) row_to_bf16_ssq(x + (size_t)m * DM, hb + (size_t)m * DM, ssq + (size_t)m * 4, lane); }
        { const float* mem = IN_mem; bf16* memb = WSP(bf16, WS_MEMB); float* ssqm = WSP(float, WS_SSQM);
          for (int m = gw; m < MROWS; m += NGW) row_to_bf16_ssq(mem + (size_t)m * DM, memb + (size_t)m * DM, ssqm + (size_t)m * 4, lane); }
    }
    if (inp(27) == nullptr) grid.sync();
    xcd_barrier(bar);

    {
        PHASE_BEGIN;
        pg8::Gemm g{WSP(bf16, WS_MEMB), WSP(bf16, WS_WKV), MROWS, 2 * MEMW, DM}; pg8::StaticOrder S; S.init(MROWS, 2 * MEMW, Gl, bxl);
        pg8::EpiHead E{WSP(bf16, WS_MEMKV), 2 * MEMW, WSP(float, WS_SSQM), 0, 1, 0, 0, 0, 0, -1, IN_mem_k_norm_g, nullptr, nullptr, 1.f, 1.f, 1.f, nullptr, nullptr};
        pg8::gemm_phase<pg8::EpiHead, pg8::StaticOrder, true, true>(L, g, S, E);
    }
#pragma unroll 1
    for (int layer_ = 0; layer_ < 2; ++layer_) {
#pragma unroll 1
        for (int f_ = 0; f_ < 2; ++f_) {
            int layer = layer_, f = f_; asm volatile("" : "+s"(layer), "+s"(f));
            if (f == 1) {
                { PHASE_BEGIN;
                  pg8::Gemm g{WSP(bf16, WS_HB), layer ? WSP(bf16, WS_WFOX) : WSP(bf16, WS_WLRU), M, layer ? N_FOX_GEMM : N_LRU, DM}; pg8::StaticOrder S; S.init(M, layer ? N_FOX_GEMM : N_LRU, Gl, bxl);
                  const float* mq = IN_memq_norm_g;
                  pg8::EpiHead E = layer ? pg8::EpiHead{WSP(bf16, WS_R), N_FOX, WSP(float, WS_SSQ), 0, 3, 3, 6, 9, 10, -1, IN_fox_q_norm_g, IN_fox_k_norm_g, mq + HD, C2, 1.f, C2, nullptr, nullptr}
                                         : pg8::EpiHead{WSP(bf16, WS_R), N_LRU, WSP(float, WS_SSQ), 6, 7, 0, 0, 0, 0, -1, mq, nullptr, nullptr, C2, 1.f, 1.f, nullptr, nullptr};
                  pg8::gemm_phase<pg8::EpiHead, pg8::StaticOrder, true, true>(L, g, S, E); }
                if (layer) { PHASE_BEGIN;
                  for (int u = vcul; u < M / 128; u += Gl) fgate_unit(u, WSP(bf16, WS_HB), WSP(bf16, WS_WFOX) + (size_t)N_FOX_GEMM * DM, WSP(float, WS_SSQ), IN_fox_b_f, WSP(float, WS_LOGF)); }
                xcd_barrier(bar);
                if (layer == 0) {
                    for (int rep_ = 0; rep_ < 1 + PROBE_DUP_MIX + PROBE_DUP_MIX0; ++rep_) {
                    { PHASE_BEGIN;
                      for (int u = vcul; u < BATCH * NH * 16; u += Gl) { const int c = u & 15, bh = u >> 4;
                        lru::unit_a(bh / NH, bh % NH, c, WSP(bf16, WS_R), IN_lru_conv_w, IN_lru_conv_b, WSP(bf16, WS_WRG), WSP(bf16, WS_WIG), IN_lru_b_rg, IN_lru_b_ig, IN_lru_lambda, WSP(bf16, WS_CAT), WSP(bf16, WS_R + R_AL), WSP(float, WS_SUMM), L); } }
                    { PHASE_BEGIN; bf16* R = WSP(bf16, WS_R); bf16* memKV = WSP(bf16, WS_MEMKV); bf16* cat = WSP(bf16, WS_CAT);
                      for (int u = vcul; u < BATCH * 4 * 16; u += Gl) { const int b = u >> 6, hm = (u >> 4) & 3, qb = u & 15;
                        attn_body::attn_unit<false, 24>((const attn_body::bf16*)(R + (size_t)(b * SEQ + qb * 256) * N_LRU + 2 * MIXW + hm * HD), N_LRU,
                            (const attn_body::bf16*)(memKV + (size_t)(b * NMEM) * 2 * MEMW + hm * HD), (const attn_body::bf16*)(memKV + (size_t)(b * NMEM) * 2 * MEMW + MEMW + hm * HD), 2 * MEMW,
                            (attn_body::bf16*)(cat + (size_t)(b * SEQ + qb * 256) * DM + MIXW + hm * HD), DM, 4, nullptr, (char*)lds); } }
                    }
                    xcd_barrier(bar);
                    { PHASE_BEGIN;
                      for (int u = vcul; u < BATCH * NH * 16; u += Gl) { const int c = u & 15, bh = u >> 4; lru::unit_b(bh / NH, bh % NH, c, WSP(bf16, WS_R), WSP(bf16, WS_R + R_AL), WSP(float, WS_SUMM), WSP(bf16, WS_CAT), L); } }
                    xcd_barrier(bar);
                } else {
                    { PHASE_BEGIN; for (int s = bxl; s < BATCH * NH; s += Gl) cumsum_unit(WSP(float, WS_LOGF), WSP(float, WS_CK), s, L); }
                    xcd_barrier(bar);
                    for (int rep_ = 0; rep_ < 1 + PROBE_DUP_MIX; ++rep_) {
                    { PHASE_BEGIN; bf16* R = WSP(bf16, WS_R); bf16* cat = WSP(bf16, WS_CAT); const float* ck2 = WSP(float, WS_CK);
                      for (int p = vcul; p < BATCH * NH * 8; p += Gl) { const int bh = p >> 3, s = p & 7, b = bh / NH, h = bh % NH;
#pragma unroll 1
                        for (int k = 0; k < 2; ++k) { const int qb = k ? 15 - s : s;
                            attn_body::attn_unit<true, 24>((const attn_body::bf16*)(R + (size_t)(b * SEQ + qb * 256) * N_FOX + h * HD), N_FOX,
                                (const attn_body::bf16*)(R + (size_t)(b * SEQ) * N_FOX + MIXW + h * HD), (const attn_body::bf16*)(R + (size_t)(b * SEQ) * N_FOX + 2 * MIXW + h * HD), N_FOX,
                                (attn_body::bf16*)(cat + (size_t)(b * SEQ + qb * 256) * DM + h * HD), DM, 4 * qb + 4, ck2 + (size_t)bh * SEQ, (char*)lds); } } }
                    { PHASE_BEGIN; bf16* R = WSP(bf16, WS_R); bf16* memKV = WSP(bf16, WS_MEMKV); bf16* cat = WSP(bf16, WS_CAT);
                      for (int u = vcul; u < BATCH * 4 * 16; u += Gl) { const int b = u >> 6, hm = (u >> 4) & 3, qb = u & 15;
                        attn_body::attn_unit<false, 24>((const attn_body::bf16*)(R + (size_t)(b * SEQ + qb * 256) * N_FOX + 3 * MIXW + hm * HD), N_FOX,
                            (const attn_body::bf16*)(memKV + (size_t)(b * NMEM) * 2 * MEMW + hm * HD), (const attn_body::bf16*)(memKV + (size_t)(b * NMEM) * 2 * MEMW + MEMW + hm * HD), 2 * MEMW,
                            (attn_body::bf16*)(cat + (size_t)(b * SEQ + qb * 256) * DM + MIXW + hm * HD), DM, 4, nullptr, (char*)lds); } }
                    }
                    xcd_barrier(bar);
                }
                { PHASE_BEGIN;
                  pg8::Gemm g{WSP(bf16, WS_CAT), (const bf16*)(wsl + (layer ? WS_WOUT1 : WS_WOUT0)), M, DM, DM}; pg8::StaticOrder S; S.init(M, DM, Gl, bxl);
                  pg8::EpiRes<false> E{WSP(bf16, WS_HB), nullptr, WSP(float, WS_SSQ), (LAS float*)(L + XS_OFF)};
                  pg8::gemm_phase<pg8::EpiRes<false>, pg8::StaticOrder, true, true>(L, g, S, E); }
                xcd_barrier(bar);
            }
            const int s = layer * 2 + f;
            { PHASE_BEGIN;
              pg8::Gemm g{WSP(bf16, WS_HB), (const bf16*)(wsl + WS_W1 + s * W1_BYTES), M, 2 * DFF, DM}; pg8::StaticOrder S; S.init(M, 2 * DFF, Gl, bxl);
              pg8::EpiSwiglu E{WSP(bf16, WS_R), WSP(float, WS_SSQ)};
              for (int rep_ = 0; rep_ < 1 + PROBE_DUP_G1; ++rep_) { pg8::gemm_phase<pg8::EpiSwiglu, pg8::StaticOrder, true, true>(L, g, S, E); if (PROBE_DUP_G1) xcd_barrier(bar); } }
            xcd_barrier(bar);
            for (int rep_ = 0; rep_ < PROBE_SYNCS; ++rep_) xcd_barrier(bar);
            { PHASE_BEGIN; float* out = (float*)inp(26);
              pg8::Gemm g{WSP(bf16, WS_R), (const bf16*)(wsl + WS_W2 + s * W2_BYTES), M, DM, DFF}; pg8::StaticOrder S; S.init(M, DM, Gl, bxl);
              const bool last = (s == 3);
              pg8::EpiRes<true> E{WSP(bf16, WS_HB), last ? out : nullptr, WSP(float, WS_SSQ), (LAS float*)(L + XS_OFF)};
              pg8::gemm_phase<pg8::EpiRes<true>, pg8::StaticOrder, true, true>(L, g, S, E); }
            if (s != 3) xcd_barrier(bar);
        }
    }
}

extern "C" void kernel_launch(void* const* d_in, const int* in_sizes, int n_in, void* d_out, int out_size, void* d_ws, size_t ws_size, hipStream_t stream) {
    static int grid = 0;
    if (grid == 0) {
        if (n_in != 26 || in_sizes[0] != M * DM || out_size != M * DM || ws_size < WS_END) { fprintf(stderr, "kernel_launch: unexpected shapes (n_in %d, in0 %d, out %d, ws %zu)\n", n_in, n_in > 0 ? in_sizes[0] : -1, out_size, ws_size); grid = -1; return; }
        int dev = 0, cus = 0, per_cu = 0;
        if (hipGetDevice(&dev) != hipSuccess || hipDeviceGetAttribute(&cus, hipDeviceAttributeMultiprocessorCount, dev) != hipSuccess) { grid = -1; return; }
        if (hipFuncSetAttribute((const void*)mega_fwd, hipFuncAttributeMaxDynamicSharedMemorySize, LDS_BYTES) != hipSuccess) { fprintf(stderr, "kernel_launch: hipFuncSetAttribute failed\n"); grid = -1; return; }
        if (hipOccupancyMaxActiveBlocksPerMultiprocessor(&per_cu, (const void*)mega_fwd, NWAVES * 64, LDS_BYTES) != hipSuccess || per_cu < 1) { fprintf(stderr, "kernel_launch: occupancy query says %d\n", per_cu); per_cu = 1; }
        (void)hipGetLastError();
        grid = cus * 1;
    }
    if (grid < 0) return;
    if (hipMemsetAsync(d_ws, 0, XCD_BAR_WORDS * sizeof(unsigned), stream) != hipSuccess) { fprintf(stderr, "kernel_launch: hipMemsetAsync of the barrier words failed\n"); return; }
    Args a{};
    for (int i = 0; i < 26; ++i) a.in[i] = (const float*)d_in[i];
    a.out = (float*)d_out; a.ws = (unsigned char*)d_ws;
    void* params[] = {&a};
    hipError_t e = hipLaunchCooperativeKernel((const void*)mega_fwd, dim3(grid), dim3(NWAVES * 64), params, LDS_BYTES, stream);
    if (e != hipSuccess) fprintf(stderr, "kernel_launch: cooperative launch failed: %s (grid %d)\n", hipGetErrorString(e), grid);
}
```
